# Optimizing an MI355X kernel written in HIP

```python
import math
import jax, jax.numpy as jnp
from jax import lax
import numpy as np

D_MODEL = 1024
BATCH = 32
SEQ = 2048
DEPTH = 2

N_MIXERS = 2
NORM_EPS = 1e-6

CONV_WIDTH = 3

MLA_HEADS = 16
MLA_Q_LORA = 384
MLA_KV_LORA = 256
MLA_NOPE = 64
MLA_ROPE = 32
MLA_V = 64
ROPE_THETA = 10000.0
Q_BLOCK = 128

PEER_HEADS = 8
PEER_N_KEYS = 128
PEER_N_EXPERTS = PEER_N_KEYS * PEER_N_KEYS
PEER_TOPK = 16
PEER_D_QUERY = 256
PEER_D_HALF = PEER_D_QUERY // 2
PEER_TOKEN_BLOCK = 128

kernel_name = 'hybrid_conv_mla_peer_encoder'


def rmsnorm(x, g):
    x32 = x.astype(jnp.float32)
    y = x32 * lax.rsqrt(jnp.mean(x32 * x32, axis=-1, keepdims=True) + NORM_EPS)
    return (y * g.astype(jnp.float32)).astype(x.dtype)


def short_conv_mixer(xn, w_in, conv_w, w_out):
    proj = xn @ w_in
    b_gate, c_gate, h = jnp.split(proj, 3, axis=-1)
    u = c_gate * h
    pad = CONV_WIDTH // 2
    y = lax.conv_general_dilated(
        u, conv_w[:, None, :].astype(u.dtype), window_strides=(1,),
        padding=[(pad, pad)], dimension_numbers=('NWC', 'WIO', 'NWC'),
        feature_group_count=D_MODEL)
    return (b_gate * y) @ w_out


def apply_rope(x, cos, sin):
    x1, x2 = jnp.split(x, 2, axis=-1)
    return jnp.concatenate([x1 * cos - x2 * sin, x2 * cos + x1 * sin], axis=-1)


def mla_mixer(xn, w_in, q_norm, kv_norm, w_uq, w_ukv, w_o):
    bsz, seq, _ = xn.shape
    lat = xn @ w_in
    c_q, c_kv, k_rope = jnp.split(lat, [MLA_Q_LORA, MLA_Q_LORA + MLA_KV_LORA], axis=-1)
    c_q = rmsnorm(c_q, q_norm)
    c_kv = rmsnorm(c_kv, kv_norm)
    q = (c_q @ w_uq).reshape(bsz, seq, MLA_HEADS, MLA_NOPE + MLA_ROPE)
    q_nope, q_rope = jnp.split(q, [MLA_NOPE], axis=-1)
    kv = (c_kv @ w_ukv).reshape(bsz, seq, MLA_HEADS, MLA_NOPE + MLA_V)
    k_nope, v = jnp.split(kv, [MLA_NOPE], axis=-1)

    pos = jnp.arange(seq, dtype=jnp.float32)
    inv_freq = ROPE_THETA ** (-jnp.arange(0, MLA_ROPE, 2, dtype=jnp.float32) / MLA_ROPE)
    ang = pos[:, None] * inv_freq[None, :]
    cos = jnp.cos(ang).astype(xn.dtype)
    sin = jnp.sin(ang).astype(xn.dtype)
    q_rope = apply_rope(q_rope, cos[None, :, None, :], sin[None, :, None, :])
    k_rope = apply_rope(k_rope, cos[None], sin[None])

    scale = (MLA_NOPE + MLA_ROPE) ** -0.5
    n_blocks = seq // Q_BLOCK
    qn_b = q_nope.reshape(bsz, n_blocks, Q_BLOCK, MLA_HEADS, MLA_NOPE).transpose(1, 0, 2, 3, 4)
    qr_b = q_rope.reshape(bsz, n_blocks, Q_BLOCK, MLA_HEADS, MLA_ROPE).transpose(1, 0, 2, 3, 4)

    def attend(args):
        qn, qr = args
        s = (jnp.einsum('bqhd,bkhd->bhqk', qn, k_nope)
             + jnp.einsum('bqhr,bkr->bhqk', qr, k_rope))
        p = jax.nn.softmax(s.astype(jnp.float32) * scale, axis=-1).astype(v.dtype)
        return jnp.einsum('bhqk,bkhd->bqhd', p, v)

    o = lax.map(attend, (qn_b, qr_b))
    o = o.transpose(1, 0, 2, 3, 4).reshape(bsz, seq, MLA_HEADS * MLA_V)
    return o @ w_o


def peer_ffn(xn, w_q, k1, k2, u_tab, v_tab):
    bsz, seq, d = xn.shape
    t = bsz * seq
    xt = xn.reshape(t, d)
    q = (xt @ w_q).reshape(t, PEER_HEADS, 2, PEER_D_HALF)
    s1 = jnp.einsum('thd,hnd->thn', q[:, :, 0], k1).astype(jnp.float32)
    s2 = jnp.einsum('thd,hnd->thn', q[:, :, 1], k2).astype(jnp.float32)
    v1, i1 = lax.top_k(s1, PEER_TOPK)
    v2, i2 = lax.top_k(s2, PEER_TOPK)
    kk = PEER_TOPK * PEER_TOPK
    cand = (v1[..., :, None] + v2[..., None, :]).reshape(t, PEER_HEADS, kk)
    cidx = (i1[..., :, None] * PEER_N_KEYS + i2[..., None, :]).reshape(t, PEER_HEADS, kk)
    top_s, top_pos = lax.top_k(cand, PEER_TOPK)
    eidx = jnp.take_along_axis(cidx, top_pos, axis=-1)
    g = jax.nn.softmax(top_s, axis=-1).astype(xn.dtype)

    nb = t // PEER_TOKEN_BLOCK

    def expert_block(args):
        xb, ib, gb = args
        u = jnp.take(u_tab, ib, axis=0)
        a = jnp.einsum('thkd,td->thk', u, xb)
        h = jax.nn.gelu(a, approximate=False) * gb
        vv = jnp.take(v_tab, ib, axis=0)
        return jnp.einsum('thk,thkd->td', h, vv)

    out = lax.map(expert_block, (xt.reshape(nb, PEER_TOKEN_BLOCK, d),
                                 eidx.reshape(nb, PEER_TOKEN_BLOCK, PEER_HEADS, PEER_TOPK),
                                 g.reshape(nb, PEER_TOKEN_BLOCK, PEER_HEADS, PEER_TOPK)))
    return out.reshape(bsz, seq, d)


def setup_inputs(seed: int = 0) -> dict:
    key = jax.random.key(seed)
    ks = jax.random.split(key, 24)
    f32 = jnp.float32
    n_conv = (DEPTH + N_MIXERS - 1) // N_MIXERS
    n_mla = DEPTH // N_MIXERS

    def nrm(k, shape, scale):
        return jax.random.normal(k, shape, f32) * scale

    def gain(k, shape):
        return 1.0 + 0.02 * jax.random.normal(k, shape, f32)

    d = D_MODEL
    return {
        'x': jax.random.normal(ks[0], (BATCH, SEQ, d), f32),
        'norm_mix': gain(ks[1], (DEPTH, d)),
        'norm_ffn': gain(ks[2], (DEPTH, d)),
        'conv_w_in': nrm(ks[3], (n_conv, d, 3 * d), d ** -0.5),
        'conv_w': nrm(ks[4], (n_conv, CONV_WIDTH, d), CONV_WIDTH ** -0.5),
        'conv_w_out': nrm(ks[5], (n_conv, d, d), d ** -0.5),
        'mla_w_in': nrm(ks[6], (n_mla, d, MLA_Q_LORA + MLA_KV_LORA + MLA_ROPE), d ** -0.5),
        'mla_q_norm': gain(ks[7], (n_mla, MLA_Q_LORA)),
        'mla_kv_norm': gain(ks[8], (n_mla, MLA_KV_LORA)),
        'mla_w_uq': nrm(ks[9], (n_mla, MLA_Q_LORA, MLA_HEADS * (MLA_NOPE + MLA_ROPE)), MLA_Q_LORA ** -0.5),
        'mla_w_ukv': nrm(ks[10], (n_mla, MLA_KV_LORA, MLA_HEADS * (MLA_NOPE + MLA_V)), MLA_KV_LORA ** -0.5),
        'mla_w_o': nrm(ks[11], (n_mla, MLA_HEADS * MLA_V, d), (MLA_HEADS * MLA_V) ** -0.5),
        'peer_w_q': nrm(ks[12], (DEPTH, d, PEER_HEADS * PEER_D_QUERY), d ** -0.5),
        'peer_k1': nrm(ks[13], (DEPTH, PEER_HEADS, PEER_N_KEYS, PEER_D_HALF), PEER_D_HALF ** -0.5),
        'peer_k2': nrm(ks[14], (DEPTH, PEER_HEADS, PEER_N_KEYS, PEER_D_HALF), PEER_D_HALF ** -0.5),
        'peer_u': nrm(ks[15], (DEPTH, PEER_N_EXPERTS, d), d ** -0.5),
        'peer_v': nrm(ks[16], (DEPTH, PEER_N_EXPERTS, d), PEER_HEADS ** -0.5),
        'final_norm': gain(ks[17], (d,)),
    }


def reference(x, norm_mix, norm_ffn, conv_w_in, conv_w, conv_w_out,
              mla_w_in, mla_q_norm, mla_kv_norm, mla_w_uq, mla_w_ukv, mla_w_o,
              peer_w_q, peer_k1, peer_k2, peer_u, peer_v, final_norm):
    for i in range(DEPTH):
        j = i // N_MIXERS
        xn = rmsnorm(x, norm_mix[i])
        if i % N_MIXERS == 0:
            mix = short_conv_mixer(xn, conv_w_in[j], conv_w[j], conv_w_out[j])
        else:
            mix = mla_mixer(xn, mla_w_in[j], mla_q_norm[j], mla_kv_norm[j],
                            mla_w_uq[j], mla_w_ukv[j], mla_w_o[j])
        x = x + mix
        x = x + peer_ffn(rmsnorm(x, norm_ffn[i]), peer_w_q[i], peer_k1[i], peer_k2[i],
                         peer_u[i], peer_v[i])
    return rmsnorm(x, final_norm)
```

```cpp
#include <hip/hip_runtime.h>
#include <math.h>
#include <stdint.h>

#define DM 1024
#define SEQ 2048
#define NB 32
#define NTOK (NB * SEQ)
#define CB 8
#define TC (CB * SEQ)

__device__ __forceinline__ float wave_sum(float v) {
#pragma unroll
  for (int o = 32; o >= 1; o >>= 1) v += __shfl_xor(v, o, 64);
  return v;
}

__global__ void __launch_bounds__(256) rmsnorm_kernel(const float* in, int ld_in, const float* g,
                                                      float* out, int ld_out, int W) {
  int row = blockIdx.x;
  const float* p = in + (size_t)row * ld_in;
  float ss = 0.f;
  for (int i = threadIdx.x; i < W; i += 256) { float v = p[i]; ss += v * v; }
  __shared__ float red[4];
  ss = wave_sum(ss);
  if ((threadIdx.x & 63) == 0) red[threadIdx.x >> 6] = ss;
  __syncthreads();
  float tot = red[0] + red[1] + red[2] + red[3];
  float r = rsqrtf(tot / (float)W + 1e-6f);
  float* q = out + (size_t)row * ld_out;
  for (int i = threadIdx.x; i < W; i += 256) { float v = p[i]; q[i] = v * r * g[i]; }
}

__global__ void __launch_bounds__(256) gemm_f32(const float* __restrict__ A, int lda,
                                                const float* __restrict__ B, int sbk, int sbn,
                                                float* C, int ldc, const float* R, int ldr,
                                                int M, int N, int K) {
  __shared__ float As[16][64 + 1];
  __shared__ float Bs[16][64 + 1];
  int tid = threadIdx.x;
  int tx = tid & 15, ty = tid >> 4;
  int m0 = blockIdx.y * 64, n0 = blockIdx.x * 64;
  float acc[4][4];
#pragma unroll
  for (int i = 0; i < 4; i++)
#pragma unroll
    for (int j = 0; j < 4; j++) acc[i][j] = 0.f;
  for (int k0 = 0; k0 < K; k0 += 16) {
#pragma unroll
    for (int r = 0; r < 4; r++) {
      int idx = tid + r * 256;
      int m = idx >> 4, k = idx & 15;
      As[k][m] = A[(size_t)(m0 + m) * lda + k0 + k];
      int kk = idx >> 6, n = idx & 63;
      float bv = 0.f;
      if (n0 + n < N) bv = B[(size_t)(k0 + kk) * sbk + (size_t)(n0 + n) * sbn];
      Bs[kk][n] = bv;
    }
    __syncthreads();
#pragma unroll
    for (int k = 0; k < 16; k++) {
      float a[4], b[4];
#pragma unroll
      for (int i = 0; i < 4; i++) a[i] = As[k][ty * 4 + i];
#pragma unroll
      for (int j = 0; j < 4; j++) b[j] = Bs[k][tx * 4 + j];
#pragma unroll
      for (int i = 0; i < 4; i++)
#pragma unroll
        for (int j = 0; j < 4; j++) acc[i][j] += a[i] * b[j];
    }
    __syncthreads();
  }
#pragma unroll
  for (int i = 0; i < 4; i++)
#pragma unroll
    for (int j = 0; j < 4; j++) {
      int m = m0 + ty * 4 + i, n = n0 + tx * 4 + j;
      if (n < N) {
        float v = acc[i][j];
        if (R) v += R[(size_t)m * ldr + n];
        C[(size_t)m * ldc + n] = v;
      }
    }
}

__global__ void __launch_bounds__(256) conv_gate_kernel(const float* proj, const float* cw, float* z) {
  size_t idx = (size_t)blockIdx.x * 256 + threadIdx.x;
  int d = (int)(idx & 1023);
  int t = (int)(idx >> 10);
  int s = t & (SEQ - 1);
  const float* pr = proj + (size_t)t * 3072;
  float y = cw[1 * DM + d] * (pr[1024 + d] * pr[2048 + d]);
  if (s > 0) y += cw[0 * DM + d] * (pr[-3072 + 1024 + d] * pr[-3072 + 2048 + d]);
  if (s < SEQ - 1) y += cw[2 * DM + d] * (pr[3072 + 1024 + d] * pr[3072 + 2048 + d]);
  z[idx] = pr[d] * y;
}

__device__ __forceinline__ void wave_argmax(float& v, int& i) {
#pragma unroll
  for (int o = 32; o >= 1; o >>= 1) {
    float ov = __shfl_xor(v, o, 64);
    int oi = __shfl_xor(i, o, 64);
    if (ov > v || (ov == v && oi < i)) { v = ov; i = oi; }
  }
}

__global__ void __launch_bounds__(256) peer_topk_kernel(const float* scores, int* eidx, float* gate) {
  int lane = threadIdx.x & 63;
  int w = blockIdx.x * 4 + (threadIdx.x >> 6);
  int t = w >> 3, h = w & 7;
  const float* sp = scores + (size_t)t * 2048 + h * 256;
  const float NEG = -INFINITY;
  float tv[2];
  int ti[2];
#pragma unroll
  for (int half = 0; half < 2; half++) {
    float sa = sp[half * 128 + lane], sb = sp[half * 128 + 64 + lane];
    float myv = 0.f;
    int myi = 0;
    for (int r = 0; r < 16; r++) {
      float v;
      int i;
      if (sa >= sb) { v = sa; i = lane; } else { v = sb; i = lane + 64; }
      wave_argmax(v, i);
      if (lane == r) { myv = v; myi = i; }
      if (i == lane) sa = NEG;
      if (i == lane + 64) sb = NEG;
    }
    tv[half] = myv;
    ti[half] = myi;
  }
  float cv[4];
  float v1 = __shfl(tv[0], lane >> 2, 64);
#pragma unroll
  for (int k = 0; k < 4; k++) cv[k] = v1 + __shfl(tv[1], (lane & 3) * 4 + k, 64);
  float tops = 0.f;
  int topc = 0;
  for (int r = 0; r < 16; r++) {
    float v = cv[0];
    int c = lane * 4;
#pragma unroll
    for (int k = 1; k < 4; k++)
      if (cv[k] > v) { v = cv[k]; c = lane * 4 + k; }
    wave_argmax(v, c);
    if (lane == r) { tops = v; topc = c; }
#pragma unroll
    for (int k = 0; k < 4; k++)
      if (c == lane * 4 + k) cv[k] = NEG;
  }
  int e = __shfl(ti[0], topc >> 4, 64) * 128 + __shfl(ti[1], topc & 15, 64);
  float mx = __shfl(tops, 0, 64);
  float ex = (lane < 16) ? expf(tops - mx) : 0.f;
  float sum = wave_sum(ex);
  if (lane < 16) {
    eidx[(size_t)w * 16 + lane] = e;
    gate[(size_t)w * 16 + lane] = ex / sum;
  }
}

__global__ void __launch_bounds__(256) peer_expert_kernel(const float* xn, const int* eidx, const float* gate,
                                                          const float* utab, const float* vtab, float* xres) {
  int t = blockIdx.x;
  int lane = threadIdx.x & 63, wv = threadIdx.x >> 6;
  float x[16], acc[16];
#pragma unroll
  for (int i = 0; i < 16; i++) { x[i] = xn[(size_t)t * DM + i * 64 + lane]; acc[i] = 0.f; }
  for (int j = wv * 32; j < wv * 32 + 32; j++) {
    int e = eidx[(size_t)t * 128 + j];
    float g = gate[(size_t)t * 128 + j];
    const float* ur = utab + (size_t)e * DM;
    float a = 0.f;
#pragma unroll
    for (int i = 0; i < 16; i++) a += ur[i * 64 + lane] * x[i];
    a = wave_sum(a);
    float hh = 0.5f * a * (1.f + erff(a * 0.70710678118654752440f)) * g;
    const float* vr = vtab + (size_t)e * DM;
#pragma unroll
    for (int i = 0; i < 16; i++) acc[i] += hh * vr[i * 64 + lane];
  }
  __shared__ float red[4][DM];
#pragma unroll
  for (int i = 0; i < 16; i++) red[wv][i * 64 + lane] = acc[i];
  __syncthreads();
  for (int d = threadIdx.x; d < DM; d += 256) {
    float s = red[0][d] + red[1][d] + red[2][d] + red[3][d];
    xres[(size_t)t * DM + d] += s;
  }
}

__global__ void __launch_bounds__(256) rope_kernel(float* q, const float* lat, float* kr) {
  size_t idx = (size_t)blockIdx.x * 256 + threadIdx.x;
  int i = (int)(idx & 15);
  int hh = (int)((idx >> 4) % 17);
  int t = (int)(idx / (17 * 16));
  int pos = t & (SEQ - 1);
  float inv = powf(10000.0f, -(float)(2 * i) / 32.0f);
  float ang = (float)pos * inv;
  float c = cosf(ang), s = sinf(ang);
  if (hh < 16) {
    float* p = q + (size_t)t * 1536 + hh * 96 + 64;
    float x1 = p[i], x2 = p[16 + i];
    p[i] = x1 * c - x2 * s;
    p[16 + i] = x2 * c + x1 * s;
  } else {
    const float* p = lat + (size_t)t * 672 + 640;
    float x1 = p[i], x2 = p[16 + i];
    kr[(size_t)t * 32 + i] = x1 * c - x2 * s;
    kr[(size_t)t * 32 + 16 + i] = x2 * c + x1 * s;
  }
}

__global__ void __launch_bounds__(256) attn_naive_kernel(const float* q, const float* kv, const float* kr, float* o) {
  int qpos = blockIdx.x * 256 + threadIdx.x;
  int h = blockIdx.y, b = blockIdx.z;
  const float scale = 0.10206207261596575f;
  float qv[96];
  const float* qp = q + ((size_t)b * SEQ + qpos) * 1536 + h * 96;
#pragma unroll
  for (int d = 0; d < 96; d++) qv[d] = qp[d] * scale;
  float acc[64];
#pragma unroll
  for (int d = 0; d < 64; d++) acc[d] = 0.f;
  float m = -INFINITY, l = 0.f;
  for (int key = 0; key < SEQ; key++) {
    const float* kp = kv + ((size_t)b * SEQ + key) * 2048 + h * 128;
    const float* rp = kr + ((size_t)b * SEQ + key) * 32;
    float s = 0.f;
#pragma unroll
    for (int d = 0; d < 64; d++) s += qv[d] * kp[d];
#pragma unroll
    for (int d = 0; d < 32; d++) s += qv[64 + d] * rp[d];
    float mn = fmaxf(m, s);
    float corr = expf(m - mn);
    float p = expf(s - mn);
    l = l * corr + p;
#pragma unroll
    for (int d = 0; d < 64; d++) acc[d] = acc[d] * corr + p * kp[64 + d];
    m = mn;
  }
  float inv = 1.f / l;
  float* op = o + ((size_t)b * SEQ + qpos) * 1024 + h * 64;
#pragma unroll
  for (int d = 0; d < 64; d++) op[d] = acc[d] * inv;
}

static void gemm(hipStream_t st, const float* A, int lda, const float* B, int sbk, int sbn, float* C, int ldc,
                 const float* R, int ldr, int M, int N, int K) {
  dim3 grid((N + 63) / 64, M / 64);
  gemm_f32<<<grid, 256, 0, st>>>(A, lda, B, sbk, sbn, C, ldc, R, ldr, M, N, K);
}

static void peer_layer(hipStream_t st, float* xres, const float* gnorm, const float* wq, const float* k1,
                       const float* k2, const float* ut, const float* vt, float* w_xn, float* w_q, float* w_sc,
                       int* w_idx, float* w_gate) {
  rmsnorm_kernel<<<TC, 256, 0, st>>>(xres, DM, gnorm, w_xn, DM, DM);
  gemm(st, w_xn, DM, wq, 2048, 1, w_q, 2048, nullptr, 0, TC, 2048, DM);
  for (int h = 0; h < 8; h++) {
    gemm(st, w_q + h * 256, 2048, k1 + (size_t)h * 128 * 128, 1, 128, w_sc + h * 256, 2048, nullptr, 0, TC, 128, 128);
    gemm(st, w_q + h * 256 + 128, 2048, k2 + (size_t)h * 128 * 128, 1, 128, w_sc + h * 256 + 128, 2048, nullptr, 0,
         TC, 128, 128);
  }
  peer_topk_kernel<<<TC * 8 / 4, 256, 0, st>>>(w_sc, w_idx, w_gate);
  peer_expert_kernel<<<TC, 256, 0, st>>>(w_xn, w_idx, w_gate, ut, vt, xres);
}

extern "C" void kernel_launch(void* const* d_in, const int* in_sizes, int n_in, void* d_out, int out_size,
                              void* d_ws, size_t ws_size, hipStream_t stream) {
  const float* x = (const float*)d_in[0];
  const float* norm_mix = (const float*)d_in[1];
  const float* norm_ffn = (const float*)d_in[2];
  const float* conv_w_in = (const float*)d_in[3];
  const float* conv_w = (const float*)d_in[4];
  const float* conv_w_out = (const float*)d_in[5];
  const float* mla_w_in = (const float*)d_in[6];
  const float* mla_q_norm = (const float*)d_in[7];
  const float* mla_kv_norm = (const float*)d_in[8];
  const float* mla_w_uq = (const float*)d_in[9];
  const float* mla_w_ukv = (const float*)d_in[10];
  const float* mla_w_o = (const float*)d_in[11];
  const float* peer_w_q = (const float*)d_in[12];
  const float* peer_k1 = (const float*)d_in[13];
  const float* peer_k2 = (const float*)d_in[14];
  const float* peer_u = (const float*)d_in[15];
  const float* peer_v = (const float*)d_in[16];
  const float* final_norm = (const float*)d_in[17];
  float* out = (float*)d_out;

  float* ws = (float*)d_ws;
  float* w_xn = ws;
  float* w_big = w_xn + (size_t)TC * 1024;
  float* w_z = w_big + (size_t)TC * 3072;
  float* w_sc = w_z + (size_t)TC * 1024;
  float* w_gate = w_sc + (size_t)TC * 2048;
  int* w_idx = (int*)(w_gate + (size_t)TC * 128);
  float* w_cq = (float*)(w_idx + (size_t)TC * 128);
  float* w_ckv = w_cq + (size_t)TC * 384;
  float* w_kr = w_ckv + (size_t)TC * 256;

  for (int c = 0; c < NB / CB; c++) {
    const float* xc = x + (size_t)c * TC * DM;
    float* oc = out + (size_t)c * TC * DM;
    rmsnorm_kernel<<<TC, 256, 0, stream>>>(xc, DM, norm_mix, w_xn, DM, DM);
    gemm(stream, w_xn, DM, conv_w_in, 3072, 1, w_big, 3072, nullptr, 0, TC, 3072, DM);
    conv_gate_kernel<<<TC * 1024 / 256, 256, 0, stream>>>(w_big, conv_w, w_z);
    gemm(stream, w_z, DM, conv_w_out, DM, 1, oc, DM, xc, DM, TC, DM, DM);
    peer_layer(stream, oc, norm_ffn, peer_w_q, peer_k1, peer_k2, peer_u, peer_v, w_xn, w_big, w_sc, w_idx, w_gate);
    rmsnorm_kernel<<<TC, 256, 0, stream>>>(oc, DM, norm_mix + DM, w_xn, DM, DM);
    float* w_lat = w_z;
    gemm(stream, w_xn, DM, mla_w_in, 672, 1, w_lat, 672, nullptr, 0, TC, 672, DM);
    rmsnorm_kernel<<<TC, 256, 0, stream>>>(w_lat, 672, mla_q_norm, w_cq, 384, 384);
    rmsnorm_kernel<<<TC, 256, 0, stream>>>(w_lat + 384, 672, mla_kv_norm, w_ckv, 256, 256);
    float* w_q = w_big;
    float* w_kv = w_sc;
    gemm(stream, w_cq, 384, mla_w_uq, 1536, 1, w_q, 1536, nullptr, 0, TC, 1536, 384);
    gemm(stream, w_ckv, 256, mla_w_ukv, 2048, 1, w_kv, 2048, nullptr, 0, TC, 2048, 256);
    rope_kernel<<<(TC * 17 * 16) / 256, 256, 0, stream>>>(w_q, w_lat, w_kr);
    float* w_o = w_xn;
    attn_naive_kernel<<<dim3(SEQ / 256, 16, CB), 256, 0, stream>>>(w_q, w_kv, w_kr, w_o);
    gemm(stream, w_o, DM, mla_w_o, DM, 1, oc, DM, oc, DM, TC, DM, DM);
    peer_layer(stream, oc, norm_ffn + DM, peer_w_q + (size_t)DM * 2048, peer_k1 + (size_t)8 * 128 * 128,
               peer_k2 + (size_t)8 * 128 * 128, peer_u + (size_t)16384 * DM, peer_v + (size_t)16384 * DM, w_xn,
               w_big, w_sc, w_idx, w_gate);
    rmsnorm_kernel<<<TC, 256, 0, stream>>>(oc, DM, final_norm, oc, DM, DM);
  }
}
```

```cpp
#include <hip/hip_runtime.h>
#include <hip/hip_cooperative_groups.h>
#include <stdint.h>
#include <math.h>
#include <cstdio>
namespace cg = cooperative_groups;

__device__ __forceinline__ int opaque_tid() { int t = threadIdx.x; asm volatile("" : "+v"(t)); return t; }
namespace pg8 {
#define PG8_LAS __attribute__((address_space(3)))
typedef unsigned short bf16_t;
typedef short bf16x8 __attribute__((ext_vector_type(8)));
typedef float f32x4 __attribute__((ext_vector_type(4)));
typedef unsigned u32x4 __attribute__((ext_vector_type(4)));
constexpr int BM = 256, BK = 64, HALF = 128, HTB = HALF * BK * 2  , STAGE_BYTES = 8 * HTB, NXCD = 8, WGM = 8;

__host__ __device__ __forceinline__ int lds_byte(int r, int c) { const int st = (r >> 4) * 2 + (c >> 5), rr = r & 15, cc = c & 31, ob = rr * 64 + cc * 2; return st * 1024 + (ob ^ (((ob >> 9) & 1) << 5)); }
__host__ __device__ __forceinline__ void stage_rc(int b, int& R, int& C) { const int st = b / 1024, sb = b % 1024, swz = sb ^ (((sb >> 9) & 1) << 5); R = (st >> 1) * 16 + swz / 64; C = (st & 1) * 32 + (swz % 64) / 2; }
__host__ __device__ __forceinline__ int perm32(int rho) { const int n = rho >> 4, i = rho & 15; return 8 * (i >> 2) + 4 * n + (i & 3); }

struct Unit { int pm, pn; };
struct Gemm { const bf16_t* A; const bf16_t* Bt; int M, N, K; };

struct StaticOrder {
    int nM, nN, nwg, G, c;
    __host__ __device__ void init(int M, int N, int G_, int c_) { nM = M / BM; nN = N / BM; nwg = nM * nN; G = G_; c = c_; }
    __host__ __device__ bool next(int i, Unit& u) const {
        const long L = (long)i * G + c; if (L >= nwg) return false;
        int wgid = (int)L; { const int q = nwg / NXCD, r = nwg % NXCD, xcd = wgid % NXCD, off = wgid / NXCD; wgid = (xcd < r ? xcd * (q + 1) : r * (q + 1) + (xcd - r) * q) + off; }
        const int nig = WGM * nN, gid = wgid / nig, fm = gid * WGM, gsz = (nM - fm) < WGM ? (nM - fm) : WGM;
        u.pm = fm + ((wgid % nig) % gsz); u.pn = (wgid % nig) / gsz; return true;
    }
    __device__ __forceinline__ void a_ready(const Unit&) const {}
    __device__ __forceinline__ void done(const Unit&) const {}
};
__device__ __forceinline__ unsigned cvt_pk_bf16(float lo, float hi) { unsigned r; asm volatile("v_cvt_pk_bf16_f32 %0, %1, %2" : "=v"(r) : "v"(lo), "v"(hi)); return r; }
typedef float f32x2 __attribute__((ext_vector_type(2)));
__device__ __forceinline__ f32x2 gelu_pk(f32x2 v) {
    const f32x2 av = __builtin_elementwise_abs(v), d = av * 0.2316418882f + 1.0f;
    f32x2 t; t.x = __builtin_amdgcn_rcpf(d.x); t.y = __builtin_amdgcn_rcpf(d.y);
    f32x2 q = t * 0.5307027145f + (-0.7265760135f); q = q * t + 0.7107068705f; q = q * t + (-0.142248368f); q = q * t + 0.127414796f; q = q * t;
    const f32x2 s = (v * v) * (-0.72134752044f);
    f32x2 e; e.x = __builtin_amdgcn_exp2f(s.x); e.y = __builtin_amdgcn_exp2f(s.y);
    const f32x2 m = v * (q * e), r = v - m;
    f32x2 o; o.x = v.x < 0.f ? m.x : r.x; o.y = v.y < 0.f ? m.y : r.y; return o;
}

struct EpiF32 {
    static constexpr bool PERM = false, AFTER_DRAIN = false;
    float* C; int ldc; const float* bias;
    __device__ __forceinline__ void operator()(const f32x4 (&acc)[2][2][4][2], const Unit& u, int wr, int wc, int fr, int fq) const {
        asm volatile("" : "+v"(fr), "+v"(fq));
        const int row0 = u.pm * BM + wr * 64 + fr, col0 = u.pn * BM + wc * 32 + 4 * fq;
        f32x4 bv[2][2];
#pragma unroll
        for (int bj = 0; bj < 2; ++bj)
#pragma unroll
            for (int n = 0; n < 2; ++n) bv[bj][n] = bias ? *(const f32x4*)(bias + col0 + bj * HALF + n * 16) : (f32x4){0.f, 0.f, 0.f, 0.f};
#pragma unroll
        for (int ai = 0; ai < 2; ++ai)
#pragma unroll
            for (int m = 0; m < 4; ++m) { float* rowp = C + (size_t)(row0 + ai * HALF + m * 16) * ldc + col0;
#pragma unroll
                for (int bj = 0; bj < 2; ++bj)
#pragma unroll
                    for (int n = 0; n < 2; ++n) *(f32x4*)(rowp + bj * HALF + n * 16) = acc[ai][bj][m][n] + bv[bj][n]; }
    }
};
template <int ACT  > struct EpiBf16 {
    static constexpr bool PERM = true, AFTER_DRAIN = false;
    bf16_t* O; int ldc; const float* bias; int split_cols; size_t split_stride;
    __device__ __forceinline__ void operator()(const f32x4 (&acc)[2][2][4][2], const Unit& u, int wr, int wc, int fr, int fq) const {
        asm volatile("" : "+v"(fr), "+v"(fq));
        const int row0 = u.pm * BM + wr * 64 + fr; int colt = u.pn * BM; bf16_t* base = O;
        if (split_cols) { const int t = colt / split_cols; base += (size_t)t * split_stride; colt -= t * split_cols; }
        const int col0 = colt + wc * 32 + 8 * fq, bcol0 = u.pn * BM + wc * 32 + 8 * fq;
        f32x4 bv[2][2];
#pragma unroll
        for (int bj = 0; bj < 2; ++bj)
#pragma unroll
            for (int n = 0; n < 2; ++n) bv[bj][n] = bias ? *(const f32x4*)(bias + bcol0 + bj * HALF + 4 * n) : (f32x4){0.f, 0.f, 0.f, 0.f};
#pragma unroll
        for (int ai = 0; ai < 2; ++ai)
#pragma unroll
            for (int m = 0; m < 4; ++m) { bf16_t* rowp = base + (size_t)(row0 + ai * HALF + m * 16) * ldc + col0;
#pragma unroll
                for (int bj = 0; bj < 2; ++bj) { f32x4 v0 = acc[ai][bj][m][0] + bv[bj][0], v1 = acc[ai][bj][m][1] + bv[bj][1];
                    if (ACT == 1) { f32x2 a = gelu_pk((f32x2){v0[0], v0[1]}), b = gelu_pk((f32x2){v0[2], v0[3]}), c = gelu_pk((f32x2){v1[0], v1[1]}), d = gelu_pk((f32x2){v1[2], v1[3]});
                        v0 = (f32x4){a.x, a.y, b.x, b.y}; v1 = (f32x4){c.x, c.y, d.x, d.y}; }
                    if (ACT == 2) {
#pragma unroll
                        for (int j = 0; j < 4; ++j) { v0[j] = 0.5f * v0[j] * (1.0f + erff(v0[j] * 0.70710678f)); v1[j] = 0.5f * v1[j] * (1.0f + erff(v1[j] * 0.70710678f)); } }
                    u32x4 w; w.x = cvt_pk_bf16(v0[0], v0[1]); w.y = cvt_pk_bf16(v0[2], v0[3]); w.z = cvt_pk_bf16(v1[0], v1[1]); w.w = cvt_pk_bf16(v1[2], v1[3]);
                    *(u32x4*)(rowp + bj * HALF) = w; } }
    }
};
template <class Epi, class Sched, bool STAMP = false>
__device__ __forceinline__ void gemm_phase(PG8_LAS unsigned char* lds, const Gemm g, const Sched& S, const Epi& E, unsigned long long* stamps) {
    const int tid = opaque_tid(), wid = __builtin_amdgcn_readfirstlane(tid >> 6), lane = tid & 63, wr = wid >> 2, wc = wid & 3, fr = lane & 15, fq = lane >> 4;
    int K = g.K; asm volatile("" : "+s"(K));
    const int nt = K / BK;
    int ts_lo = 0, ts_hi = 0, nts = 0; const unsigned long long rt_entry = STAMP ? (unsigned long long)wall_clock64() : 0ull;
#define PG8_STAMP() do { if (STAMP && wid == 0 && nts < 64) { const unsigned long long _c = (unsigned long long)clock64(); \
        ts_lo = (lane == nts) ? (int)(unsigned)_c : ts_lo; ts_hi = (lane == nts) ? (int)(unsigned)(_c >> 32) : ts_hi; ++nts; } } while (0)
    PG8_STAMP();
    unsigned voffA[2], voffB[2];
#pragma unroll
    for (int i = 0; i < 2; ++i) { int R, C; stage_rc(tid * 16 + i * 8192, R, C); const int Rb = Epi::PERM ? ((R & ~31) + perm32(R & 31)) : R;
        voffA[i] = (unsigned)(R * K + C) * 2u; voffB[i] = (unsigned)(Rb * K + C) * 2u; }
    const size_t kstep = (size_t)(BK * 2);
    const size_t hstep = (size_t)HALF * K * 2;
    const size_t tstep = 2 * hstep;
    const unsigned ldsw = (unsigned)wid * 1024u;
    const int aoff = lds_byte(wr * 64 + fr, fq * 8), boff = lds_byte(wc * 32 + fr, fq * 8);
#define PG8_SA(b, h) (((b) * 2 + (h)) * HTB)
#define PG8_SB(b, h) ((4 + (b) * 2 + (h)) * HTB)
#define PG8_STAGE(bufoff, gbase, voff) do { _Pragma("unroll") for (int _i = 0; _i < 2; ++_i) \
        __builtin_amdgcn_global_load_lds((const unsigned*)((const char*)(gbase) + (voff)[_i]), (PG8_LAS unsigned*)(lds + (bufoff) + ldsw + _i * 8192), 16, 0, 0); } while (0)
#define PG8_LDA(dst, b, h) do { _Pragma("unroll") for (int m = 0; m < 4; ++m) _Pragma("unroll") for (int k = 0; k < 2; ++k) dst[m][k] = *(const PG8_LAS bf16x8*)(lds + PG8_SA(b, h) + aoff + m * 2048 + k * 1024); } while (0)
#define PG8_LDB(dst, b, h) do { _Pragma("unroll") for (int n = 0; n < 2; ++n) _Pragma("unroll") for (int k = 0; k < 2; ++k) dst[n][k] = *(const PG8_LAS bf16x8*)(lds + PG8_SB(b, h) + boff + n * 2048 + k * 1024); } while (0)
#define PG8_MMA(ai, bj, At, Bt) do { __builtin_amdgcn_s_setprio(1); _Pragma("unroll") for (int m = 0; m < 4; ++m) _Pragma("unroll") for (int n = 0; n < 2; ++n) _Pragma("unroll") for (int k = 0; k < 2; ++k) \
        acc[ai][bj][m][n] = __builtin_amdgcn_mfma_f32_16x16x32_bf16(Bt[n][k], At[m][k], acc[ai][bj][m][n], 0, 0, 0); __builtin_amdgcn_s_setprio(0); } while (0)
#define PG8_WAIT_V(n) asm volatile("s_waitcnt vmcnt(" #n ")" ::: "memory")
#define PG8_WAIT_L(n) asm volatile("s_waitcnt lgkmcnt(" #n ")" ::: "memory")
#define PG8_BAR __builtin_amdgcn_s_barrier()
#define PG8_SCHED __builtin_amdgcn_sched_barrier(0)
    Unit cur, nxt; int ui = 0;
    if (!S.next(0, cur)) return;
    f32x4 acc[2][2][4][2];
#pragma unroll
    for (int a = 0; a < 2; ++a)
#pragma unroll
        for (int b = 0; b < 2; ++b)
#pragma unroll
            for (int m = 0; m < 4; ++m)
#pragma unroll
                for (int n = 0; n < 2; ++n) acc[a][b][m][n] = (f32x4){0.f, 0.f, 0.f, 0.f};
    bf16x8 At[4][2], B0[2][2], B1[2][2];
    const char* cA = (const char*)g.A + (size_t)cur.pm * tstep; const char* cB = (const char*)g.Bt + (size_t)cur.pn * tstep;
    S.a_ready(cur);
    PG8_STAGE(PG8_SB(0, 0), cB, voffB); PG8_STAGE(PG8_SA(0, 0), cA, voffA); PG8_STAGE(PG8_SB(0, 1), cB + hstep, voffB); PG8_STAGE(PG8_SA(0, 1), cA + hstep, voffA);
    if (wr == 1) PG8_BAR;
    PG8_WAIT_V(4); PG8_BAR;
    PG8_STAGE(PG8_SB(1, 0), cB + kstep, voffB); PG8_STAGE(PG8_SA(1, 0), cA + kstep, voffA); PG8_STAGE(PG8_SB(1, 1), cB + hstep + kstep, voffB);
    PG8_WAIT_V(6); PG8_BAR;
    PG8_STAMP();
    for (;;) {
        const bool has_next = S.next(ui + 1, nxt);
        const char* nA = has_next ? (const char*)g.A + (size_t)nxt.pm * tstep : cA; const char* nB = has_next ? (const char*)g.Bt + (size_t)nxt.pn * tstep : cB;
        for (int t = 0; t < nt; t += 2) {
            const bool last = (t == nt - 2);
            const char* a1 = cA + (size_t)(t + 1) * kstep;
            const char* a2 = last ? nA : cA + (size_t)(t + 2) * kstep; const char* b2 = last ? nB : cB + (size_t)(t + 2) * kstep;
            const char* a3 = a2 + kstep; const char* b3 = b2 + kstep;
            if (last && has_next) S.a_ready(nxt);
            PG8_LDB(B0, 0, 0); PG8_SCHED; PG8_LDA(At, 0, 0); PG8_STAGE(PG8_SA(1, 1), a1 + hstep, voffA);
            PG8_WAIT_L(8); PG8_BAR; PG8_WAIT_L(0); PG8_MMA(0, 0, At, B0); PG8_BAR; PG8_SCHED;
            PG8_LDB(B1, 0, 1); PG8_STAGE(PG8_SB(0, 0), b2, voffB);
            PG8_BAR; PG8_WAIT_L(0); PG8_MMA(0, 1, At, B1); PG8_BAR;
            PG8_LDA(At, 0, 1); PG8_STAGE(PG8_SA(0, 0), a2, voffA);
            PG8_BAR; PG8_WAIT_L(0); PG8_MMA(1, 0, At, B0); PG8_BAR; PG8_SCHED;
            PG8_STAGE(PG8_SB(0, 1), b2 + hstep, voffB);
            PG8_WAIT_V(6); PG8_BAR; PG8_MMA(1, 1, At, B1); PG8_BAR;
            PG8_LDB(B0, 1, 0); PG8_SCHED; PG8_LDA(At, 1, 0); PG8_STAGE(PG8_SA(0, 1), a2 + hstep, voffA);
            PG8_WAIT_L(8); PG8_BAR; PG8_WAIT_L(0); PG8_MMA(0, 0, At, B0); PG8_BAR; PG8_SCHED;
            PG8_LDB(B1, 1, 1); PG8_STAGE(PG8_SB(1, 0), b3, voffB);
            PG8_BAR; PG8_WAIT_L(0); PG8_MMA(0, 1, At, B1); PG8_BAR;
            PG8_LDA(At, 1, 1); PG8_STAGE(PG8_SA(1, 0), a3, voffA);
            PG8_BAR; PG8_WAIT_L(0); PG8_MMA(1, 0, At, B0); PG8_BAR; PG8_SCHED;
            PG8_STAGE(PG8_SB(1, 1), b3 + hstep, voffB);
            PG8_WAIT_V(6); PG8_BAR; PG8_MMA(1, 1, At, B1); PG8_BAR;
        }
        PG8_STAMP();
        if constexpr (!Epi::AFTER_DRAIN) { E(acc, cur, wr, wc, fr, fq); S.done(cur); }
        PG8_STAMP();
        if (!has_next) break;
#pragma unroll
        for (int a = 0; a < 2; ++a)
#pragma unroll
            for (int b = 0; b < 2; ++b)
#pragma unroll
                for (int m = 0; m < 4; ++m)
#pragma unroll
                    for (int n = 0; n < 2; ++n) acc[a][b][m][n] = (f32x4){0.f, 0.f, 0.f, 0.f};
        cur = nxt; cA = nA; cB = nB; ++ui;
    }
    PG8_WAIT_V(0);
    if (wr == 0) PG8_BAR;
    PG8_BAR;
    if constexpr (Epi::AFTER_DRAIN) { E.fused(acc, cur, wr, wc, fr, fq, lds, wid, lane); S.done(cur); }
    PG8_STAMP();
    if (STAMP && wid == 0) { stamps[lane] = lane < nts ? (((unsigned long long)(unsigned)ts_hi << 32) | (unsigned)ts_lo) : 0ull;
        if (lane == 62) stamps[62] = rt_entry; if (lane == 63) stamps[63] = (unsigned long long)wall_clock64(); }
#undef PG8_STAMP
#undef PG8_SA
#undef PG8_SB
#undef PG8_STAGE
#undef PG8_LDA
#undef PG8_LDB
#undef PG8_MMA
#undef PG8_WAIT_V
#undef PG8_WAIT_L
#undef PG8_BAR
#undef PG8_SCHED
}
}


using pg8::bf16_t; using pg8::bf16x8; using pg8::f32x4; using pg8::u32x4;
typedef float f32x2v __attribute__((ext_vector_type(2)));
typedef unsigned u32x2 __attribute__((ext_vector_type(2)));
#define LAS __attribute__((address_space(3)))

#define XB_TMO      128
#define XB_XCNT(j)  (256  + 64 * (j))
#define XB_XSUB(j)  (1280 + 64 * (j))
#define XB_XGEN(j)  (2304 + 64 * (j))
#define XB_TOP      3328
#define XB_TOPGEN   3392
#define XCD_BAR_WORDS 3456
#define XB_SPIN_CAP (1u << 18)

__device__ __forceinline__ unsigned xb_ld(unsigned* p)              { return __hip_atomic_load(p, __ATOMIC_RELAXED, __HIP_MEMORY_SCOPE_AGENT); }
__device__ __forceinline__ unsigned xb_add(unsigned* p, unsigned v) { return __hip_atomic_fetch_add(p, v, __ATOMIC_RELAXED, __HIP_MEMORY_SCOPE_AGENT); }
__device__ __forceinline__ unsigned xb_xcc_id() { return (unsigned)__builtin_amdgcn_s_getreg((3 << 11) | 20) & 0xFu; }
#define XB_SPIN(cond, bar) do { unsigned _sp = 0; while (cond) { __builtin_amdgcn_s_sleep(1); \
    if ((++_sp & 255u) == 0u) { if (xb_ld(&(bar)[XB_TMO])) break; if (_sp > XB_SPIN_CAP) { atomicAdd(&(bar)[XB_TMO], 1u); break; } } } } while (0)

struct XcdBarrier {
    unsigned* bar; unsigned x;
    volatile LAS unsigned* st;
};

__device__ __forceinline__ XcdBarrier xcd_barrier_post(unsigned* bar, volatile LAS unsigned* st) {
    XcdBarrier b; b.bar = bar; b.x = xb_xcc_id(); b.st = st;
    if (threadIdx.x == 0) (void)xb_add(&bar[XB_XCNT(b.x)], 1u);
    return b;
}
__device__ __forceinline__ void xcd_barrier_complete(unsigned* bar, unsigned x, unsigned& nloc, unsigned& nx) {
    const unsigned G = gridDim.x * gridDim.y * gridDim.z;
    unsigned sum, cnt, mine, sp = 0u;
    for (;;) {
        sum = 0u; cnt = 0u; mine = 0u;
#pragma unroll
        for (unsigned j = 0; j < 16; ++j) { const unsigned c = xb_ld(&bar[XB_XCNT(j)]); sum += c; cnt += (c > 0u) ? 1u : 0u; mine = (j == x) ? c : mine; }
        if (sum == G) break;
        __builtin_amdgcn_s_sleep(1);
        if ((++sp & 255u) == 0u) { if (xb_ld(&bar[XB_TMO])) break; if (sp > XB_SPIN_CAP) { atomicAdd(&bar[XB_TMO], 1u); break; } }
    }
    nloc = mine > 0u ? mine : 1u; nx = cnt > 0u ? cnt : 1u;
}

__device__ __forceinline__ void xcd_barrier(const XcdBarrier& b) {
    asm volatile("s_waitcnt vmcnt(0)" ::: "memory");
    __syncthreads();
    if (threadIdx.x == 0) {
        unsigned* bar = b.bar;
        __builtin_amdgcn_s_waitcnt(0);
        unsigned nloc = b.st[0], nx = b.st[1];
        if (nloc == 0u) { xcd_barrier_complete(bar, b.x, nloc, nx); b.st[0] = nloc; b.st[1] = nx; }
        const unsigned old = xb_add(&bar[XB_XSUB(b.x)], 1u);
        const unsigned gen = old / nloc;
        if (old + 1u == (gen + 1u) * nloc) {
            __builtin_amdgcn_fence(__ATOMIC_RELEASE, "agent");
            asm volatile("s_waitcnt vmcnt(0)" ::: "memory");
            const unsigned og = xb_add(&bar[XB_TOP], 1u);
            const unsigned tg = og / nx;
            if (og + 1u == (tg + 1u) * nx) xb_add(&bar[XB_TOPGEN], 1u);
            else XB_SPIN(xb_ld(&bar[XB_TOPGEN]) == tg, bar);
            __builtin_amdgcn_fence(__ATOMIC_ACQUIRE, "agent");
            xb_add(&bar[XB_XGEN(b.x)], 1u);
            asm volatile("s_waitcnt vmcnt(0)" ::: "memory");
        } else {
            XB_SPIN(xb_ld(&bar[XB_XGEN(b.x)]) == gen, bar);
            __builtin_amdgcn_fence(__ATOMIC_ACQUIRE, "agent");
            asm volatile("s_waitcnt vmcnt(0)" ::: "memory");
        }
    }
    __syncthreads();
}

constexpr int T = 65536, DM = 1024, SEQ = 2048;
constexpr float EPS = 1e-6f;
constexpr float SU = 512.f, SV = 32.f;
constexpr float SX = 16.f;
constexpr int LDS_BYTES = 160 * 1024;

constexpr size_t al256(size_t x) { return (x + 255) / 256 * 256; }
constexpr size_t WS_BT1 = 0;
constexpr size_t WS_BT2 = WS_BT1 + al256((size_t)3072 * 1024 * 2);
constexpr size_t WS_BT3 = WS_BT2 + al256((size_t)1024 * 1024 * 2);
constexpr size_t WS_BT5 = WS_BT3 + al256((size_t)2 * 2048 * 1024 * 2);
constexpr size_t WS_BT6 = WS_BT5 + al256((size_t)768 * 1024 * 2);
constexpr size_t WS_BT7 = WS_BT6 + al256((size_t)1536 * 384 * 2);
constexpr size_t WS_BT9 = WS_BT7 + al256((size_t)2048 * 256 * 2);
constexpr size_t WS_ROPE = WS_BT9 + al256((size_t)1024 * 1024 * 2);
constexpr size_t WS_UT8 = WS_ROPE + al256((size_t)2 * 2048 * 16 * 4);
constexpr size_t WS_VT8 = WS_UT8 + al256((size_t)2 * 16384 * 1024);
constexpr size_t WS_SSQ = WS_VT8 + al256((size_t)2 * 16384 * 1024);
constexpr size_t WS_SSQ2 = WS_SSQ + al256((size_t)T * 16 * 4);
constexpr size_t WS_ASC = WS_SSQ2 + al256((size_t)T * 8 * 4);
constexpr size_t WS_XB = WS_ASC + al256((size_t)T * 4);
constexpr size_t WS_BIG = WS_XB + al256((size_t)T * 1024 * 2);
constexpr size_t BIG_BYTES = (size_t)T * 2048 * 4;
constexpr size_t WS_MISC = WS_BIG + BIG_BYTES;
constexpr size_t MS_IDX = 0;
constexpr size_t MS_GATE = MS_IDX + (size_t)T * 128 * 4;
constexpr size_t MS_X3B = MS_GATE + (size_t)T * 128 * 4;
constexpr size_t MS_CQ = MS_X3B;
constexpr size_t MS_CKV = MS_CQ + (size_t)T * 384 * 2;
constexpr size_t MS_KR = MS_CKV + (size_t)T * 256 * 2;
static_assert(MS_KR + (size_t)T * 32 * 2 <= MS_X3B + (size_t)T * 1024 * 2, "cq/ckv/kr inside the x3b slot");
constexpr size_t MISC_BYTES = MS_X3B + (size_t)T * 1024 * 2;
constexpr size_t WS_BAR = WS_MISC + MISC_BYTES;
constexpr size_t WS_END = WS_BAR + al256((size_t)XCD_BAR_WORDS * 4) + 8192;
constexpr size_t BG_XQ = (size_t)384 * 1024 * 1024;
constexpr size_t BG_SLOTS = (size_t)352 * 1024 * 1024;
constexpr size_t BG_SCORES = (size_t)64 * 1024 * 1024;
constexpr size_t BG_UB = 0, BG_BB = (size_t)T * 1024 * 2;
constexpr size_t BG_LATQ = 0, BG_KV = (size_t)T * 768 * 4;
static_assert(BG_KV + (size_t)T * 2048 * 2 <= BIG_BYTES, "mla buffers fit");

struct Params { const float* in[18]; float* out; unsigned char* ws; int ph_lo, ph_hi; };

__device__ __forceinline__ float row16_sum(float v) {
  v += __int_as_float(__builtin_amdgcn_update_dpp(0, __float_as_int(v), 0x128, 0xf, 0xf, false));
  v += __int_as_float(__builtin_amdgcn_update_dpp(0, __float_as_int(v), 0x124, 0xf, 0xf, false));
  v += __int_as_float(__builtin_amdgcn_update_dpp(0, __float_as_int(v), 0x122, 0xf, 0xf, false));
  v += __int_as_float(__builtin_amdgcn_update_dpp(0, __float_as_int(v), 0x121, 0xf, 0xf, false));
  return v;
}
__device__ __forceinline__ float wave_sum(float v) {
  v = row16_sum(v);
  v += __shfl_xor(v, 16, 64); v += __shfl_xor(v, 32, 64);
  return v;
}
__device__ __forceinline__ unsigned pkbf(float lo, float hi) { return pg8::cvt_pk_bf16(lo, hi); }
__device__ __forceinline__ float bflo(unsigned w) { return __uint_as_float(w << 16); }
__device__ __forceinline__ float bfhi(unsigned w) { return __uint_as_float(w & 0xffff0000u); }

template <class F>
__device__ __forceinline__ void tr_convert(const float* __restrict__ src, int N, int K, bf16_t* __restrict__ dst, int Np, F colmap, int gtid, int nthr, const float* __restrict__ kscale = nullptr) {
  const int items = Np * (K / 8);
  for (int idx = gtid; idx < items; idx += nthr) {
    const int kc = idx / Np, n = idx - kc * Np;
    const int c = colmap(n);
    float v[8];
#pragma unroll
    for (int i = 0; i < 8; i++) v[i] = (c >= 0) ? src[(size_t)(kc * 8 + i) * N + c] * (kscale ? kscale[kc * 8 + i] : 1.f) : 0.f;
    u32x4 w; w.x = pkbf(v[0], v[1]); w.y = pkbf(v[2], v[3]); w.z = pkbf(v[4], v[5]); w.w = pkbf(v[6], v[7]);
    *(u32x4*)(dst + (size_t)n * K + kc * 8) = w;
  }
}

__device__ __forceinline__ void prep_phase(const Params& p, LAS unsigned char* lds) {
  const int tid = opaque_tid(), lane = tid & 63, wid = tid >> 6;
  const int G = gridDim.x, gtid = blockIdx.x * 512 + tid, nthr = G * 512;
  const int gw = blockIdx.x * 8 + wid, nw = G * 8;
  unsigned char* ws = p.ws;
  {
    const float* x = p.in[0]; const float* g = p.in[1];
    bf16_t* xb = (bf16_t*)(ws + WS_XB);
    f32x4 gv[4];
#pragma unroll
    for (int i = 0; i < 4; i++) gv[i] = *(const f32x4*)(g + lane * 16 + i * 4);
    for (int t0 = gw; t0 < T; t0 += 2 * nw) {
      f32x4 v[2][4];
#pragma unroll
      for (int k = 0; k < 2; k++) { const int t = (t0 + k * nw < T) ? (t0 + k * nw) : t0;
#pragma unroll
        for (int i = 0; i < 4; i++) v[k][i] = *(const f32x4*)(x + (size_t)t * DM + lane * 16 + i * 4); }
#pragma unroll
      for (int k = 0; k < 2; k++) {
        const int t = t0 + k * nw;
        float ss = 0.f;
#pragma unroll
        for (int i = 0; i < 4; i++) ss += v[k][i].x * v[k][i].x + v[k][i].y * v[k][i].y + v[k][i].z * v[k][i].z + v[k][i].w * v[k][i].w;
        ss = wave_sum(ss);
        const float r = rsqrtf(ss * (1.f / DM) + EPS);
        u32x4 w0, w1;
        w0.x = pkbf(v[k][0].x * r * gv[0].x, v[k][0].y * r * gv[0].y); w0.y = pkbf(v[k][0].z * r * gv[0].z, v[k][0].w * r * gv[0].w);
        w0.z = pkbf(v[k][1].x * r * gv[1].x, v[k][1].y * r * gv[1].y); w0.w = pkbf(v[k][1].z * r * gv[1].z, v[k][1].w * r * gv[1].w);
        w1.x = pkbf(v[k][2].x * r * gv[2].x, v[k][2].y * r * gv[2].y); w1.y = pkbf(v[k][2].z * r * gv[2].z, v[k][2].w * r * gv[2].w);
        w1.z = pkbf(v[k][3].x * r * gv[3].x, v[k][3].y * r * gv[3].y); w1.w = pkbf(v[k][3].z * r * gv[3].z, v[k][3].w * r * gv[3].w);
        if (t < T) { *(u32x4*)(xb + (size_t)t * DM + lane * 16) = w0; *(u32x4*)(xb + (size_t)t * DM + lane * 16 + 8) = w1; }
      }
    }
  }
  tr_convert(p.in[3], 3072, 1024, (bf16_t*)(ws + WS_BT1), 3072, [](int n) {
    if (n < 1024) return n;
    const int q = n - 1024, tile = q >> 8, r = q & 255;
    return (r < 128) ? (1024 + tile * 128 + r) : (2048 + tile * 128 + (r - 128)); }, gtid, nthr);
  tr_convert(p.in[5], 1024, 1024, (bf16_t*)(ws + WS_BT2), 1024, [](int n) { return n; }, gtid, nthr);
  tr_convert(p.in[6], 672, 1024, (bf16_t*)(ws + WS_BT5), 768, [](int n) { return n < 672 ? n : -1; }, gtid, nthr, p.in[1] + DM);
  tr_convert(p.in[9], 1536, 384, (bf16_t*)(ws + WS_BT6), 1536, [](int n) { return n; }, gtid, nthr);
  tr_convert(p.in[10], 2048, 256, (bf16_t*)(ws + WS_BT7), 2048, [](int n) { return n; }, gtid, nthr);
  tr_convert(p.in[11], 1024, 1024, (bf16_t*)(ws + WS_BT9), 1024, [](int n) { return n; }, gtid, nthr);
  {
    LAS float* Wq_s = (LAS float*)lds;
    LAS float* Kh_s = (LAS float*)(lds + 64 * 128 * 4);
    for (int it = blockIdx.x; it < 512; it += G) {
      const int l = it >> 8, hh = (it >> 4) & 15, kr = it & 15, k0 = kr * 64;
      const float* Wq = p.in[12] + (size_t)l * 1024 * 2048;
      const float* Kh = ((hh & 1) ? p.in[14] : p.in[13]) + ((size_t)(l * 8 + (hh >> 1)) * 128) * 128;
      const float* gf = p.in[2] + l * DM;
      __syncthreads();
#pragma unroll
      for (int i = 0; i < 16; i++) { const int idx = tid + i * 512, r = idx >> 7, c = idx & 127; Wq_s[idx] = Wq[(size_t)(k0 + r) * 2048 + hh * 128 + c]; }
#pragma unroll
      for (int i = 0; i < 32; i++) { const int idx = tid + i * 512, n = idx >> 7, d = idx & 127; Kh_s[n * 129 + d] = Kh[idx]; }
      __syncthreads();
      const int n = tid & 127, kq = tid >> 7;
      float acc[16];
#pragma unroll
      for (int i = 0; i < 16; i++) acc[i] = 0.f;
      for (int d = 0; d < 128; d++) {
        const float kv = Kh_s[n * 129 + d];
#pragma unroll
        for (int i = 0; i < 16; i++) acc[i] += Wq_s[(kq * 16 + i) * 128 + d] * kv;
      }
      bf16_t* dst = (bf16_t*)(ws + WS_BT3) + ((size_t)l * 2048 + hh * 128 + n) * 1024 + k0 + kq * 16;
      const float* gk = gf + k0 + kq * 16;
      u32x4 w0, w1;
      w0.x = pkbf(acc[0] * gk[0], acc[1] * gk[1]); w0.y = pkbf(acc[2] * gk[2], acc[3] * gk[3]);
      w0.z = pkbf(acc[4] * gk[4], acc[5] * gk[5]); w0.w = pkbf(acc[6] * gk[6], acc[7] * gk[7]);
      w1.x = pkbf(acc[8] * gk[8], acc[9] * gk[9]); w1.y = pkbf(acc[10] * gk[10], acc[11] * gk[11]);
      w1.z = pkbf(acc[12] * gk[12], acc[13] * gk[13]); w1.w = pkbf(acc[14] * gk[14], acc[15] * gk[15]);
      *(u32x4*)dst = w0; *(u32x4*)(dst + 8) = w1;
    }
    __syncthreads();
  }
  {
    const int items = 4 * 16384 * 64;
    for (int idx0 = gtid; idx0 < items; idx0 += 2 * nthr) {
      f32x4 v[2][4], g4[2][4];
#pragma unroll
      for (int k = 0; k < 2; k++) {
        const int idx = (idx0 + k * nthr < items) ? (idx0 + k * nthr) : idx0;
        const int part = idx & 63, e = (idx >> 6) & 16383, tb = (idx >> 20) & 1, l = idx >> 21;
        const float* src = (tb ? p.in[16] : p.in[15]) + ((size_t)l * 16384 + e) * DM + part * 16;
        const float* gf = p.in[2] + l * DM + part * 16;
#pragma unroll
        for (int i = 0; i < 4; i++) { v[k][i] = *(const f32x4*)(src + i * 4); g4[k][i] = *(const f32x4*)(gf + i * 4); }
      }
#pragma unroll
      for (int k = 0; k < 2; k++) {
        const int idx = idx0 + k * nthr;
        if (idx < items) {
          const int part = idx & 63, e = (idx >> 6) & 16383, tb = (idx >> 20) & 1, l = idx >> 21;
          unsigned w[4];
#pragma unroll
          for (int i = 0; i < 4; i++) {
            f32x4 vv = v[k][i];
            if (tb == 0) vv = vv * g4[k][i] * SU; else vv = vv * SV;
            unsigned q = __builtin_amdgcn_cvt_pk_fp8_f32(vv.x, vv.y, 0u, false);
            q = __builtin_amdgcn_cvt_pk_fp8_f32(vv.z, vv.w, q, true);
            w[i] = q;
          }
          if (tb == 0) {
            *(u32x4*)(ws + WS_UT8 + ((size_t)l * 16384 + e) * 1024 + part * 16) = (u32x4){w[0], w[1], w[2], w[3]};
          } else {
            unsigned char* row = ws + WS_VT8 + (((size_t)(l * 8 + (part >> 3)) * 16384 + e) * 128);
            const int pp = part & 7;
#pragma unroll
            for (int nb = 0; nb < 8; nb++) {
              const unsigned b0 = (w[nb >> 2] >> (8 * (nb & 3))) & 0xffu;
              const unsigned b1 = (w[2 + (nb >> 2)] >> (8 * (nb & 3))) & 0xffu;
              *(unsigned short*)(row + 16 * nb + 2 * pp) = (unsigned short)(b0 | (b1 << 8));
            }
          }
        }
      }
    }
  }
  {
    float* rc = (float*)(ws + WS_ROPE); float* rs = rc + 2048 * 16;
    for (int idx = gtid; idx < 2048 * 16; idx += nthr) {
      const int pos = idx >> 4, i = idx & 15;
      const float inv = powf(10000.0f, -(float)(2 * i) / 32.0f);
      const float ang = (float)pos * inv;
      rc[idx] = cosf(ang); rs[idx] = sinf(ang);
    }
  }
}

struct EpiConv {
  static constexpr bool PERM = true, AFTER_DRAIN = false;
  bf16_t* bb; bf16_t* ub;
  __device__ __forceinline__ void operator()(const f32x4 (&acc)[2][2][4][2], const pg8::Unit& u, int wr, int wc, int fr, int fq) const {
    asm volatile("" : "+v"(fr), "+v"(fq));
    const int row0 = u.pm * 256 + wr * 64 + fr;
    if (u.pn < 4) {
      const int col0 = u.pn * 256 + wc * 32 + 8 * fq;
#pragma unroll
      for (int ai = 0; ai < 2; ++ai)
#pragma unroll
        for (int m = 0; m < 4; ++m) {
          bf16_t* rowp = bb + (size_t)(row0 + ai * 128 + m * 16) * DM + col0;
#pragma unroll
          for (int bj = 0; bj < 2; ++bj) {
            const f32x4 v0 = acc[ai][bj][m][0], v1 = acc[ai][bj][m][1];
            u32x4 w; w.x = pkbf(v0[0], v0[1]); w.y = pkbf(v0[2], v0[3]); w.z = pkbf(v1[0], v1[1]); w.w = pkbf(v1[2], v1[3]);
            *(u32x4*)(rowp + bj * 128) = w;
          }
        }
    } else {
      const int col0 = (u.pn - 4) * 128 + wc * 32 + 8 * fq;
#pragma unroll
      for (int ai = 0; ai < 2; ++ai)
#pragma unroll
        for (int m = 0; m < 4; ++m) {
          bf16_t* rowp = ub + (size_t)(row0 + ai * 128 + m * 16) * DM + col0;
          const f32x4 v0 = acc[ai][0][m][0] * acc[ai][1][m][0], v1 = acc[ai][0][m][1] * acc[ai][1][m][1];
          u32x4 w; w.x = pkbf(v0[0], v0[1]); w.y = pkbf(v0[2], v0[3]); w.z = pkbf(v1[0], v1[1]); w.w = pkbf(v1[2], v1[3]);
          *(u32x4*)rowp = w;
        }
    }
  }
};

template <bool BFRES  > struct EpiResid {
  static constexpr bool PERM = false, AFTER_DRAIN = false;
  const void* xin; bf16_t* xb; float* ssq;
  __device__ __forceinline__ void operator()(const f32x4 (&acc)[2][2][4][2], const pg8::Unit& u, int wr, int wc, int fr, int fq) const {
    asm volatile("" : "+v"(fr), "+v"(fq));
    const int row0 = u.pm * 256 + wr * 64 + fr, col0 = u.pn * 256 + wc * 32 + 4 * fq;
#pragma unroll
    for (int ai = 0; ai < 2; ++ai) {
      f32x4 rbuf[4][2][2];
#pragma unroll
      for (int m = 0; m < 4; ++m)
#pragma unroll
        for (int bj = 0; bj < 2; ++bj)
#pragma unroll
          for (int n = 0; n < 2; ++n) {
            const size_t o = (size_t)(row0 + ai * 128 + m * 16) * DM + col0 + bj * 128 + n * 16;
            if (BFRES) { const u32x2 w = *(const u32x2*)((const bf16_t*)xin + o); rbuf[m][bj][n] = (f32x4){bflo(w.x), bfhi(w.x), bflo(w.y), bfhi(w.y)}; }
            else rbuf[m][bj][n] = *(const f32x4*)((const float*)xin + o);
          }
      __builtin_amdgcn_sched_barrier(0);
#pragma unroll
      for (int m = 0; m < 4; ++m) {
        const int row = row0 + ai * 128 + m * 16;
        float s = 0.f;
#pragma unroll
        for (int bj = 0; bj < 2; ++bj)
#pragma unroll
          for (int n = 0; n < 2; ++n) {
            const size_t o = (size_t)row * DM + col0 + bj * 128 + n * 16;
            const f32x4 v = acc[ai][bj][m][n] + rbuf[m][bj][n];
            u32x2 w; w.x = pkbf(v[0], v[1]); w.y = pkbf(v[2], v[3]);
            *(u32x2*)(xb + o) = w;
            s += v[0] * v[0] + v[1] * v[1] + v[2] * v[2] + v[3] * v[3];
          }
        s += __shfl_xor(s, 16, 64); s += __shfl_xor(s, 32, 64);
        if (fq == 0) ssq[(size_t)row * 16 + u.pn * 4 + wc] = s;
      }
    }
  }
};

struct EpiQ {
  static constexpr bool PERM = false, AFTER_DRAIN = false;
  bf16_t* Q; const float* rc; const float* rs;
  __device__ __forceinline__ void operator()(const f32x4 (&acc)[2][2][4][2], const pg8::Unit& u, int wr, int wc, int fr, int fq) const {
    asm volatile("" : "+v"(fr), "+v"(fq));
    const int row0 = u.pm * 256 + wr * 64 + fr, col0 = u.pn * 256 + wc * 32 + 4 * fq;
#pragma unroll
    for (int ai = 0; ai < 2; ++ai) {
      f32x4 c4[4], s4[4];
#pragma unroll
      for (int m = 0; m < 4; ++m) { const int pos = (row0 + ai * 128 + m * 16) & (SEQ - 1);
        c4[m] = *(const f32x4*)(rc + pos * 16 + 4 * fq); s4[m] = *(const f32x4*)(rs + pos * 16 + 4 * fq); }
      __builtin_amdgcn_sched_barrier(0);
#pragma unroll
      for (int m = 0; m < 4; ++m) {
        const int row = row0 + ai * 128 + m * 16;
#pragma unroll
        for (int bj = 0; bj < 2; ++bj) {
          const int grp = u.pn * 8 + bj * 4 + wc;
          f32x4 v0 = acc[ai][bj][m][0], v1 = acc[ai][bj][m][1];
          if (grp % 3 == 2) { const f32x4 o0 = v0 * c4[m] - v1 * s4[m], o1 = v1 * c4[m] + v0 * s4[m]; v0 = o0; v1 = o1; }
          bf16_t* dst = Q + (size_t)row * 1536 + col0 + bj * 128;
          u32x2 w0, w1; w0.x = pkbf(v0[0], v0[1]); w0.y = pkbf(v0[2], v0[3]); w1.x = pkbf(v1[0], v1[1]); w1.y = pkbf(v1[2], v1[3]);
          *(u32x2*)dst = w0; *(u32x2*)(dst + 16) = w1;
        }
      }
    }
  }
};

__device__ __forceinline__ void convz_phase(const Params& p) {
  const int gtid = blockIdx.x * 512 + opaque_tid(), nthr = gridDim.x * 512;
  const bf16_t* ub = (const bf16_t*)(p.ws + WS_BIG + BG_UB);
  bf16_t* bb = (bf16_t*)(p.ws + WS_BIG + BG_BB);
  const float* cw = p.in[4];
  const int d8 = gtid & 127;
  float w0[8], w1[8], w2[8];
#pragma unroll
  for (int i = 0; i < 8; i++) { w0[i] = cw[d8 * 8 + i]; w1[i] = cw[DM + d8 * 8 + i]; w2[i] = cw[2 * DM + d8 * 8 + i]; }
  constexpr int UNR = 4;
  for (int idx0 = gtid; idx0 < T * 128; idx0 += nthr * UNR) {
    u32x4 uc[UNR], um[UNR], up[UNR], bv[UNR];
#pragma unroll
    for (int k = 0; k < UNR; k++) {
      const int idx = idx0 + k * nthr;
      const int t = idx >> 7, sq = t & (SEQ - 1);
      const size_t o = (size_t)t * DM + d8 * 8;
      um[k] = (u32x4){0u, 0u, 0u, 0u}; up[k] = (u32x4){0u, 0u, 0u, 0u}; uc[k] = um[k]; bv[k] = um[k];
      if (idx < T * 128) {
        uc[k] = *(const u32x4*)(ub + o);
        if (sq > 0) um[k] = *(const u32x4*)(ub + o - DM);
        if (sq < SEQ - 1) up[k] = *(const u32x4*)(ub + o + DM);
        bv[k] = *(const u32x4*)(bb + o);
      }
    }
#pragma unroll
    for (int k = 0; k < UNR; k++) {
      const int idx = idx0 + k * nthr;
      if (idx < T * 128) {
        const size_t o = (size_t)(idx >> 7) * DM + d8 * 8;
        unsigned ow[4];
#pragma unroll
        for (int i = 0; i < 4; i++) {
          const float ylo = w0[2 * i] * bflo(um[k][i]) + w1[2 * i] * bflo(uc[k][i]) + w2[2 * i] * bflo(up[k][i]);
          const float yhi = w0[2 * i + 1] * bfhi(um[k][i]) + w1[2 * i + 1] * bfhi(uc[k][i]) + w2[2 * i + 1] * bfhi(up[k][i]);
          ow[i] = pkbf(bflo(bv[k][i]) * ylo, bfhi(bv[k][i]) * yhi);
        }
        *(u32x4*)(bb + o) = (u32x4){ow[0], ow[1], ow[2], ow[3]};
      }
    }
  }
}

__device__ __forceinline__ int mono(float f) { const int b = __float_as_int(f); return b ^ ((b >> 31) & 0x7fffffff); }
__device__ __forceinline__ float unmono(int k) { return __int_as_float(k ^ ((k >> 31) & 0x7fffffff)); }
__device__ __forceinline__ int imax(int a, int b) { return a > b ? a : b; }
__device__ __forceinline__ int imin(int a, int b) { return a < b ? a : b; }

__device__ __forceinline__ void sort16_desc(int (&a)[16]) {
#define CE(i, j) do { const int hi_ = imax(a[i], a[j]), lo_ = imin(a[i], a[j]); a[i] = hi_; a[j] = lo_; } while (0)
  CE(0, 13); CE(1, 12); CE(2, 15); CE(3, 14); CE(4, 8); CE(5, 6); CE(7, 11); CE(9, 10);
  CE(0, 5); CE(1, 7); CE(2, 9); CE(3, 4); CE(6, 13); CE(8, 14); CE(10, 15); CE(11, 12);
  CE(0, 1); CE(2, 3); CE(4, 5); CE(6, 8); CE(7, 9); CE(10, 11); CE(12, 13); CE(14, 15);
  CE(0, 2); CE(1, 3); CE(4, 10); CE(5, 11); CE(6, 7); CE(8, 9); CE(12, 14); CE(13, 15);
  CE(1, 2); CE(3, 12); CE(4, 6); CE(5, 7); CE(8, 10); CE(9, 11); CE(13, 14);
  CE(1, 4); CE(2, 6); CE(5, 8); CE(7, 10); CE(9, 13); CE(11, 14);
  CE(2, 4); CE(3, 6); CE(9, 12); CE(11, 13);
  CE(3, 5); CE(6, 8); CE(7, 9); CE(10, 12);
  CE(3, 4); CE(5, 6); CE(7, 8); CE(9, 10); CE(11, 12);
  CE(6, 7); CE(8, 9);
#undef CE
}
__device__ __forceinline__ void merge16_desc(int (&t)[16], const int (&g)[16]) {
#pragma unroll
  for (int i = 0; i < 16; i++) t[i] = imax(t[i], g[15 - i]);
#pragma unroll
  for (int j = 8; j > 0; j >>= 1) {
#pragma unroll
    for (int i = 0; i < 16; i++) {
      const int l = i ^ j;
      if (l > i) { const int hi = imax(t[i], t[l]), lo = imin(t[i], t[l]); t[i] = hi; t[l] = lo; }
    }
  }
}

constexpr int TK_ROW = 68;
constexpr int TK_LUT_OFF = 512 * TK_ROW * 4;
constexpr int TK_LUT_STRIDE = 36;

__device__ __forceinline__ void topk_phase(const Params& p, LAS unsigned char* lds, int l) {
  const int tid = opaque_tid();
  const bf16_t* scores = (const bf16_t*)(p.ws + WS_BIG + BG_SCORES);
  const float* ssq = (const float*)(p.ws + WS_SSQ);
  int* eidx = (int*)(p.ws + WS_MISC + MS_IDX);
  float* gate = (float*)(p.ws + WS_MISC + MS_GATE);
  LAS unsigned* sl = (LAS unsigned*)lds;
  LAS unsigned char* lut = lds + TK_LUT_OFF + tid * TK_LUT_STRIDE;
#define TK_LOAD(PF, TILE, HALF) do { _Pragma("unroll") for (int it_ = 0; it_ < 16; it_++) { const int q_ = it_ * 512 + tid, pair_ = q_ >> 4, piece_ = q_ & 15; \
    PF[it_] = *(const u32x4*)(scores + (size_t)((TILE) * 64 + (pair_ >> 3)) * 2048 + (pair_ & 7) * 256 + (HALF) * 128 + piece_ * 8); } } while (0)
  u32x4 pf[16];
  if ((int)blockIdx.x < T / 64) TK_LOAD(pf, (int)blockIdx.x, 0);
  for (int tile = blockIdx.x; tile < T / 64; tile += gridDim.x) {
    const int t0 = tile * 64;
    int T1[16], T2[16];
#pragma unroll
    for (int half = 0; half < 2; half++) {
      int TT[16];
      __syncthreads();
#pragma unroll
      for (int it = 0; it < 16; it++) { const int q = it * 512 + tid, pair = q >> 4, piece = q & 15; *(LAS u32x4*)(sl + pair * TK_ROW + piece * 4) = pf[it]; }
      __syncthreads();
      if (half == 0) TK_LOAD(pf, tile, 1);
#pragma unroll
      for (int g = 0; g < 8; g++) {
        int G[16];
#pragma unroll
        for (int q4 = 0; q4 < 2; q4++) {
          const u32x4 v = *(const LAS u32x4*)(sl + tid * TK_ROW + g * 8 + q4 * 4);
#pragma unroll
          for (int j = 0; j < 4; j++) {
            const int n = g * 16 + q4 * 8 + j * 2;
            G[q4 * 8 + j * 2] = (mono(bflo(v[j])) & ~127) | (127 - n);
            G[q4 * 8 + j * 2 + 1] = (mono(bfhi(v[j])) & ~127) | (127 - (n + 1));
          }
        }
        sort16_desc(G);
        if (g == 0) {
#pragma unroll
          for (int i = 0; i < 16; i++) TT[i] = G[i];
        } else merge16_desc(TT, G);
      }
#pragma unroll
      for (int i = 0; i < 16; i++) { if (half == 0) T1[i] = TT[i]; else T2[i] = TT[i]; }
    }
    float v1[16], v2[16];
    unsigned i1w[4] = {0u, 0u, 0u, 0u}, i2w[4] = {0u, 0u, 0u, 0u};
#pragma unroll
    for (int i = 0; i < 16; i++) {
      v1[i] = unmono(T1[i] & ~127); v2[i] = unmono(T2[i] & ~127);
      i1w[i >> 2] |= (unsigned)(127 - (T1[i] & 127)) << (8 * (i & 3));
      i2w[i >> 2] |= (unsigned)(127 - (T2[i] & 127)) << (8 * (i & 3));
    }
#pragma unroll
    for (int i = 0; i < 4; i++) { *(LAS unsigned*)(lut + i * 4) = i1w[i]; *(LAS unsigned*)(lut + 16 + i * 4) = i2w[i]; }
#define CAND(i, j) ((mono(v1[i] + v2[j]) & ~255) | (255 - ((i) * 16 + (j))))
    int R[16];
#pragma unroll
    for (int j = 0; j < 16; j++) R[j] = CAND(0, j);
    {
      int G1[16] = {CAND(1, 0), CAND(1, 1), CAND(1, 2), CAND(1, 3), CAND(1, 4), CAND(1, 5), CAND(1, 6), CAND(1, 7),
                    CAND(2, 0), CAND(2, 1), CAND(2, 2), CAND(2, 3), CAND(2, 4), CAND(3, 0), CAND(3, 1), CAND(3, 2)};
      sort16_desc(G1); merge16_desc(R, G1);
      int G2[16] = {CAND(3, 3), CAND(4, 0), CAND(4, 1), CAND(4, 2), CAND(5, 0), CAND(5, 1), CAND(6, 0), CAND(6, 1),
                    CAND(7, 0), CAND(7, 1), CAND(8, 0), CAND(9, 0), CAND(10, 0), CAND(11, 0), CAND(12, 0), CAND(13, 0)};
      sort16_desc(G2); merge16_desc(R, G2);
      int xa = CAND(14, 0), xb2 = CAND(15, 0);
#pragma unroll
      for (int r = 0; r < 16; r++) { const int hi = imax(R[r], xa), lo = imin(R[r], xa); R[r] = hi; xa = lo; }
#pragma unroll
      for (int r = 0; r < 16; r++) { const int hi = imax(R[r], xb2), lo = imin(R[r], xb2); R[r] = hi; xb2 = lo; }
    }
#undef CAND
    const int t = t0 + (tid >> 3), h = tid & 7;
    float sq = 0.f;
    {
      const f32x4 a0 = *(const f32x4*)(ssq + (size_t)t * 16), a1 = *(const f32x4*)(ssq + (size_t)t * 16 + 4);
      const f32x4 a2 = *(const f32x4*)(ssq + (size_t)t * 16 + 8), a3 = *(const f32x4*)(ssq + (size_t)t * 16 + 12);
      const f32x4 a = a0 + a1 + a2 + a3; sq = a[0] + a[1] + a[2] + a[3];
    }
    const float rstd = rsqrtf(sq * (1.f / DM) + EPS);
    float ev[16]; int ex[16]; float sum = 0.f;
    const float m0 = unmono(R[0] & ~255);
#pragma unroll
    for (int r = 0; r < 16; r++) {
      const float val = unmono(R[r] & ~255);
      ev[r] = __expf((val - m0) * rstd); sum += ev[r];
      const int pos = 255 - (R[r] & 255);
      const int a = lut[pos >> 4], b = lut[16 + (pos & 15)];
      ex[r] = a * 128 + b;
    }
    const float inv = 1.f / sum;
    __syncthreads();
    {
      LAS int* el = (LAS int*)lds;
      LAS float* gl = (LAS float*)(lds + 64 * 128 * 4);
#pragma unroll
      for (int q4 = 0; q4 < 4; q4++) {
        *(LAS u32x4*)(el + (tid >> 3) * 128 + (tid & 7) * 16 + q4 * 4) = (u32x4){(unsigned)ex[q4 * 4], (unsigned)ex[q4 * 4 + 1], (unsigned)ex[q4 * 4 + 2], (unsigned)ex[q4 * 4 + 3]};
        *(LAS f32x4*)(gl + (tid >> 3) * 128 + (tid & 7) * 16 + q4 * 4) = (f32x4){ev[q4 * 4] * inv, ev[q4 * 4 + 1] * inv, ev[q4 * 4 + 2] * inv, ev[q4 * 4 + 3] * inv};
      }
      __syncthreads();
      const int lane = tid & 63, wv = tid >> 6;
      unsigned short* slots = (unsigned short*)(p.ws + WS_BIG + BG_SLOTS);
      unsigned char* xq = p.ws + WS_BIG + BG_XQ; float* asc = (float*)(p.ws + WS_ASC);
      const bf16_t* xbf = l ? (const bf16_t*)(p.ws + WS_MISC + MS_X3B) : (const bf16_t*)(p.ws + WS_XB);
      u32x4 xw0[8], xw1[8]; float xsq[8];
#pragma unroll
      for (int k = 0; k < 8; k++) { const size_t tt = (size_t)(t0 + wv * 8 + k);
        xw0[k] = *(const u32x4*)(xbf + tt * DM + lane * 16); xw1[k] = *(const u32x4*)(xbf + tt * DM + lane * 16 + 8); xsq[k] = ssq[tt * 16 + (lane & 15)]; }
#pragma unroll
      for (int k = 0; k < 8; k++) {
        const int tl = wv * 8 + k;
        const int e_lo = el[tl * 128 + lane], e_hi = el[tl * 128 + 64 + lane];
        const int b_lo = e_lo >> 11, b_hi = e_hi >> 11;
        int cb[8];
        unsigned long long mlo[8], mhi[8];
#pragma unroll
        for (int b = 0; b < 8; b++) { mlo[b] = __ballot(b_lo == b); mhi[b] = __ballot(b_hi == b); cb[b] = __popcll(mlo[b]) + __popcll(mhi[b]); }
        int pfr[9]; pfr[0] = 0;
#pragma unroll
        for (int b = 0; b < 8; b++) pfr[b + 1] = pfr[b] + (cb[b] < 16 ? 16 - cb[b] : 0);
        int pov = 0, r_lo = 0, r_hi = 0, o_lo = -1, o_hi = -1;
#pragma unroll
        for (int b = 0; b < 8; b++) {
          const int clo = __popcll(mlo[b]);
          const int klo = __builtin_amdgcn_mbcnt_hi((unsigned)(mlo[b] >> 32), __builtin_amdgcn_mbcnt_lo((unsigned)mlo[b], 0u));
          const int khi = clo + __builtin_amdgcn_mbcnt_hi((unsigned)(mhi[b] >> 32), __builtin_amdgcn_mbcnt_lo((unsigned)mhi[b], 0u));
          if (b_lo == b) { if (klo < 16) r_lo = 16 * b + klo; else o_lo = pov + klo - 16; }
          if (b_hi == b) { if (khi < 16) r_hi = 16 * b + khi; else o_hi = pov + khi - 16; }
          pov += (cb[b] > 16 ? cb[b] - 16 : 0);
        }
#pragma unroll
        for (int b = 0; b < 8; b++) {
          if (o_lo >= pfr[b] && o_lo < pfr[b + 1]) r_lo = 16 * b + cb[b] + (o_lo - pfr[b]);
          if (o_hi >= pfr[b] && o_hi < pfr[b + 1]) r_hi = 16 * b + cb[b] + (o_hi - pfr[b]);
        }
        unsigned short* sp = slots + (size_t)(t0 + tl) * 128;
        sp[r_lo] = (unsigned short)e_lo;
        sp[r_hi] = (unsigned short)e_hi;
        float* gsp = gate + (size_t)(t0 + tl) * 128;
        gsp[r_lo] = gl[tl * 128 + lane];
        gsp[r_hi] = gl[tl * 128 + 64 + lane];
        {
          const size_t tt = (size_t)(t0 + tl);
          const u32x4 w0 = xw0[k], w1 = xw1[k];
          unsigned hw[4];
#pragma unroll
          for (int i = 0; i < 4; i++) {
            const unsigned wa = (i < 2) ? w0[2 * i] : w1[2 * i - 4], wb = (i < 2) ? w0[2 * i + 1] : w1[2 * i - 3];
            const float f0 = bflo(wa) * SX, f1 = bfhi(wa) * SX, f2 = bflo(wb) * SX, f3 = bfhi(wb) * SX;
            unsigned h8 = __builtin_amdgcn_cvt_pk_fp8_f32(f0, f1, 0u, false); h8 = __builtin_amdgcn_cvt_pk_fp8_f32(f2, f3, h8, true);
            hw[i] = h8;
          }
          *(u32x4*)(xq + tt * 1024 + lane * 16) = (u32x4){hw[0], hw[1], hw[2], hw[3]};
          float sq = xsq[k];
          sq = row16_sum(sq);
          if (lane == 0) asc[tt] = rsqrtf(sq * (1.f / DM) + EPS) * (1.f / (SU * SX));
        }
      }
    }
    { const int nt = tile + (int)gridDim.x; if (nt < T / 64) TK_LOAD(pf, nt, 0); }
  }
#undef TK_LOAD
}

#define XSEL(c, a, b) ((c) ? (a) : (b))
__device__ __forceinline__ f32x2v dotacc_fp8(f32x2v s, const u32x4 q, const f32x2v (&x)[8]) {
#pragma unroll
  for (int w = 0; w < 4; w++) {
    const f32x2v lo = __builtin_amdgcn_cvt_pk_f32_fp8(q[w], false), hi = __builtin_amdgcn_cvt_pk_f32_fp8(q[w], true);
    s += lo * x[2 * w]; s += hi * x[2 * w + 1];
  }
  return s;
}
__device__ __forceinline__ float gelu_erf(float v) {
  const float av = fabsf(v), d = fmaf(av, 0.2316418882f, 1.0f), tt = __builtin_amdgcn_rcpf(d);
  float q = fmaf(tt, 0.5307027145f, -0.7265760135f); q = fmaf(q, tt, 0.7107068705f); q = fmaf(q, tt, -0.142248368f); q = fmaf(q, tt, 0.127414796f); q = q * tt;
  const float e = __builtin_amdgcn_exp2f(v * v * -0.72134752044f);
  const float m = v * (q * e);
  return v < 0.f ? m : v - m;
}

constexpr int UW_BYTES = 0;
#define U_DPP(V, CTRL) __int_as_float(__builtin_amdgcn_update_dpp(0, __float_as_int(V), (CTRL), 0xf, 0xf, false))
__device__ __forceinline__ void peer_u_phase(const Params& p, int l, LAS unsigned char* lds, const int UVAR) {
  const int tid = opaque_tid(), lane = tid & 63, wid = tid >> 6;
  const int c = blockIdx.x, s = c & 7, rank = c >> 3, nrank = (gridDim.x + 7 - s) >> 3;
  const unsigned char* ut = p.ws + WS_UT8 + (size_t)l * 16384 * 1024;
  const unsigned lpart = (unsigned)((lane >> 4) * 128 + (lane & 7) * 16);
  const unsigned short* slots = (const unsigned short*)(p.ws + WS_BIG + BG_SLOTS) + 16 * s + 8 * ((lane >> 3) & 1);
  const unsigned char* xq = p.ws + WS_BIG + BG_XQ + (lane >> 4) * 128 + (lane & 7) * 16; const float* asc = (const float*)(p.ws + WS_ASC);
  const bool b2 = (lane >> 2) & 1, c0 = ((lane ^ (lane >> 2)) & 1) != 0, c1 = (((lane >> 1) ^ (lane >> 2)) & 1) != 0;
  const bool sel1 = lane & 1, sel2 = (lane >> 1) & 1, valid = (lane >> 4) == ((lane >> 2) & 1);
  const int rho = 8 * ((lane >> 3) & 1) + (c0 ? 1 : 0) + (c1 ? 2 : 0) + (b2 ? 4 : 0);
  const float* gate = (const float*)(p.ws + WS_MISC + MS_GATE) + 16 * s + rho;
  bf16_t* abuf = ((UVAR == 0) ? (bf16_t*)(p.ws + WS_BIG) : (bf16_t*)(p.ws + WS_BIG + (size_t)400 * 1024 * 1024)) + 16 * s + rho;
  int stride = nrank * 8; asm volatile("" : "+s"(stride));
  const int t0 = rank * 8 + wid;
  if (t0 >= T) return;
  const int nit = (T - t0 + stride - 1) / stride;
#define U_TOK(I) (t0 + ((I) < nit ? (I) : nit - 1) * stride)
#define U_L64(V) ((long)(((unsigned long long)(V)[1] << 32) | (V)[0]))
#define U_H64(V) ((long)(((unsigned long long)(V)[3] << 32) | (V)[2]))
#ifdef REPEAT_U
  const unsigned umsk = (UVAR == 3) ? 2047u : 0xffffu, uorv = (UVAR == 3) ? ((unsigned)s << 11) : 0u;
#define U_OFFS(OF, IA) do { _Pragma("unroll") for (int r_ = 0; r_ < 4; r_++) { OF[2 * r_] = (((IA[r_] & umsk) | uorv) << 10) + lpart; OF[2 * r_ + 1] = ((((IA[r_] >> 16) & umsk) | uorv) << 10) + lpart; } } while (0)
#else
#define U_OFFS(OF, IA) do { _Pragma("unroll") for (int r_ = 0; r_ < 4; r_++) { OF[2 * r_] = ((IA[r_] & 0xffffu) << 10) + lpart; OF[2 * r_ + 1] = ((IA[r_] >> 16) << 10) + lpart; } } while (0)
#endif
  u32x4 tb[32], ida, idc, xr[8];
  float gvc, asc_c;
  {
    const size_t ta = (size_t)U_TOK(0), tb1 = (size_t)U_TOK(1), tc = (size_t)U_TOK(2), td = (size_t)U_TOK(3);
    const u32x4 i0a = *(const u32x4*)(slots + ta * 128);
    const u32x4 i1a = *(const u32x4*)(slots + tb1 * 128);
    __builtin_amdgcn_sched_barrier(0);
    ida = *(const u32x4*)(slots + tc * 128);
    idc = *(const u32x4*)(slots + td * 128);
    gvc = gate[ta * 128]; asc_c = asc[ta];
    xr[0] = *(const u32x4*)(xq + ta * 1024); xr[1] = *(const u32x4*)(xq + ta * 1024 + 512);
    xr[2] = *(const u32x4*)(xq + tb1 * 1024); xr[3] = *(const u32x4*)(xq + tb1 * 1024 + 512);
    __builtin_amdgcn_sched_barrier(0);
#pragma unroll
    for (int h = 0; h < 2; h++) {
      unsigned of[8]; if (h == 0) U_OFFS(of, i0a); else U_OFFS(of, i1a);
#pragma unroll
      for (int rp = 0; rp < 8; rp += 2) {
        tb[16 * h + 2 * rp] = *(const u32x4*)(ut + of[rp]); tb[16 * h + 2 * rp + 2] = *(const u32x4*)(ut + of[rp + 1]);
        tb[16 * h + 2 * rp + 1] = *(const u32x4*)(ut + of[rp] + 512); tb[16 * h + 2 * rp + 3] = *(const u32x4*)(ut + of[rp + 1] + 512);
        __builtin_amdgcn_sched_barrier(0);
      }
    }
  }
  for (int ii = 0; ii < nit; ii += 4) {
#pragma unroll
    for (int h4 = 0; h4 < 4; h4++) {
      const int i = ii + h4, h = h4 & 1;
      const int t = U_TOK(i); const size_t tn1 = (size_t)U_TOK(i + 1), tn2 = (size_t)U_TOK(i + 2), tn4 = (size_t)U_TOK(i + 4);
      unsigned of[8]; U_OFFS(of, ida);
      ida = idc;
      idc = *(const u32x4*)(slots + tn4 * 128);
      const float gvn = gate[tn1 * 128], asn = asc[tn1];
      xr[2 * ((h4 + 2) & 3)] = *(const u32x4*)(xq + tn2 * 1024); xr[2 * ((h4 + 2) & 3) + 1] = *(const u32x4*)(xq + tn2 * 1024 + 512);
      __builtin_amdgcn_sched_barrier(0);
      const long xa00 = U_L64(xr[2 * h4]), xa01 = U_H64(xr[2 * h4]), xa10 = U_L64(xr[2 * h4 + 1]), xa11 = U_H64(xr[2 * h4 + 1]);
      float v[8];
#pragma unroll
      for (int rp = 0; rp < 8; rp += 2) {
        const f32x4 z = {0.f, 0.f, 0.f, 0.f};
        const int k0 = 16 * h + 2 * rp;
        f32x4 a0 = __builtin_amdgcn_mfma_f32_16x16x32_fp8_fp8(xa00, U_L64(tb[k0]), z, 0, 0, 0);
        f32x4 a1 = __builtin_amdgcn_mfma_f32_16x16x32_fp8_fp8(xa00, U_L64(tb[k0 + 2]), z, 0, 0, 0);
        a0 = __builtin_amdgcn_mfma_f32_16x16x32_fp8_fp8(xa01, U_H64(tb[k0]), a0, 0, 0, 0);
        a1 = __builtin_amdgcn_mfma_f32_16x16x32_fp8_fp8(xa01, U_H64(tb[k0 + 2]), a1, 0, 0, 0);
        a0 = __builtin_amdgcn_mfma_f32_16x16x32_fp8_fp8(xa10, U_L64(tb[k0 + 1]), a0, 0, 0, 0);
        a1 = __builtin_amdgcn_mfma_f32_16x16x32_fp8_fp8(xa10, U_L64(tb[k0 + 3]), a1, 0, 0, 0);
        a0 = __builtin_amdgcn_mfma_f32_16x16x32_fp8_fp8(xa11, U_H64(tb[k0 + 1]), a0, 0, 0, 0);
        a1 = __builtin_amdgcn_mfma_f32_16x16x32_fp8_fp8(xa11, U_H64(tb[k0 + 3]), a1, 0, 0, 0);
        __builtin_amdgcn_sched_barrier(0);
        tb[k0] = *(const u32x4*)(ut + of[rp]); tb[k0 + 2] = *(const u32x4*)(ut + of[rp + 1]);
        tb[k0 + 1] = *(const u32x4*)(ut + of[rp] + 512); tb[k0 + 3] = *(const u32x4*)(ut + of[rp + 1] + 512);
        __builtin_amdgcn_sched_barrier(0);
        v[rp] = sel2 ? (sel1 ? a0[3] : a0[2]) : (sel1 ? a0[1] : a0[0]);
        v[rp + 1] = sel2 ? (sel1 ? a1[3] : a1[2]) : (sel1 ? a1[1] : a1[0]);
        __builtin_amdgcn_sched_barrier(0);
      }
      {
        float u[4];
#pragma unroll
        for (int k = 0; k < 4; k++) { const float keep = c0 ? v[2 * k + 1] : v[2 * k], send = c0 ? v[2 * k] : v[2 * k + 1]; const float sm = keep + U_DPP(send, 0xB1); u[k] = valid ? sm : 0.f; }
        float w[2];
#pragma unroll
        for (int k = 0; k < 2; k++) { const float keep = c1 ? u[2 * k + 1] : u[2 * k], send = c1 ? u[2 * k] : u[2 * k + 1]; w[k] = keep + U_DPP(send, 0x4E); }
        float zz = (b2 ? w[1] : w[0]) + U_DPP(b2 ? w[0] : w[1], 0x141);
        zz += __int_as_float(__builtin_amdgcn_ds_swizzle(__float_as_int(zz), 0x401F));
        const float hv = gelu_erf(zz * asc_c) * gvc;
        if (lane < 16 && i < nit) abuf[(size_t)t * 128] = (bf16_t)(pkbf(hv, 0.f) & 0xffffu);
      }
      __builtin_amdgcn_sched_barrier(0);
      gvc = gvn; asc_c = asn;
    }
  }
#undef U_TOK
#undef U_L64
#undef U_H64
#undef U_OFFS
}

constexpr float SH = 64.f;
constexpr int VM_BYTES = 768;
constexpr int VW_BYTES = 16 * 1024 + 2 * VM_BYTES + 2 * 256 + 64;
static_assert(8 * VW_BYTES <= LDS_BYTES - 64, "V phase LDS");
__device__ __forceinline__ long tr8_read(int addr) { long r; asm volatile("ds_read_b64_tr_b8 %0, %1" : "=&v"(r) : "v"(addr) : "memory"); return r; }
__device__ __forceinline__ long lds_read64(int addr) { long r; asm volatile("ds_read_b64 %0, %1" : "=&v"(r) : "v"(addr) : "memory"); return r; }
__device__ __forceinline__ void peer_v_phase(const Params& p, int l, LAS unsigned char* lds, int dry = 0) {
  const int tid = opaque_tid(), lane = tid & 63, wid = tid >> 6;
  const int c = blockIdx.x, s = c & 7, rank = c >> 3, nrank = (gridDim.x + 7 - s) >> 3;
  const unsigned char* vts = p.ws + WS_VT8 + ((size_t)(l * 8 + s) * 16384) * 128;
  const unsigned* slt = (const unsigned*)(p.ws + WS_BIG + BG_SLOTS);
  const unsigned* hbuf = (const unsigned*)(p.ws + WS_BIG);
  float* ssq2 = dry ? (float*)(p.ws + WS_BIG + (size_t)420 * 1024 * 1024) : (float*)(p.ws + WS_SSQ2);
  const bf16_t* xin = l ? (const bf16_t*)(p.ws + WS_MISC + MS_X3B) : (const bf16_t*)(p.ws + WS_XB);
  bf16_t* xb = dry ? (bf16_t*)(p.ws + WS_BIG + (size_t)330 * 1024 * 1024) : (l ? (bf16_t*)(p.ws + WS_MISC + MS_X3B) : (bf16_t*)(p.ws + WS_XB));
  LAS unsigned char* img = lds + wid * VW_BYTES;
  LAS unsigned char* mb = img + 16 * 1024;
  LAS unsigned char* hqb = mb + 2 * VM_BYTES;
  LAS unsigned char* zb = hqb + 512;
  if (lane < 16) *(LAS unsigned*)(zb + lane * 4) = 0u;
  const int n = lane & 15, q = lane >> 4, g = lane >> 3, c8 = lane & 7;
  const int tr_r = (lane & 15) >> 1, tr_cc = lane & 1;
  const int imgaddr = (int)(uintptr_t)img;
  const int pj0 = (lane & 15) * 8 + (lane >> 4), pj1 = (lane & 15) * 8 + 4 + (lane >> 4);
  int stride = nrank * 8; asm volatile("" : "+s"(stride));
  const int t0 = rank * 8 + wid;
  if (t0 >= T) return;
  const int nit = (T - t0 + stride - 1) / stride;
#define V_TOK(I) (t0 + ((I) < nit ? (I) : nit - 1) * stride)
#define V_META_DMA(B, TT) do { LAS unsigned char* m_ = mb + (B) * VM_BYTES; \
    __builtin_amdgcn_global_load_lds(slt + (size_t)(TT) * 64 + lane, (LAS unsigned*)m_, 4, 0, 0); \
    __builtin_amdgcn_global_load_lds(hbuf + (size_t)(TT) * 64 + lane, (LAS unsigned*)(m_ + 256), 4, 0, 0); \
    __builtin_amdgcn_global_load_lds((const unsigned*)(xin + (size_t)(TT) * DM + s * 128) + lane, (LAS unsigned*)(m_ + 512), 4, 0, 0); } while (0)
#define V_STAGE(B, HB, EV, XO) do { const LAS unsigned char* m_ = mb + (B) * VM_BYTES; LAS unsigned char* hq_ = hqb + (HB) * 256; \
    _Pragma("unroll") for (int i_ = 0; i_ < 2; i_++) EV[i_] = *(const LAS u32x4*)(m_ + g * 32 + i_ * 16); \
    XO = *(const LAS u32x4*)(m_ + 512 + n * 16); \
    const float f0_ = bflo((unsigned)*(const LAS unsigned short*)(m_ + 256 + lane * 2)) * SH, f1_ = bflo((unsigned)*(const LAS unsigned short*)(m_ + 384 + lane * 2)) * SH; \
    const unsigned hh_ = __builtin_amdgcn_cvt_pk_fp8_f32(f0_, f1_, 0u, false); \
    const f32x2v bk_ = __builtin_amdgcn_cvt_pk_f32_fp8(hh_, false); \
    const unsigned ll_ = __builtin_amdgcn_cvt_pk_fp8_f32((f0_ - bk_.x) * 16.f, (f1_ - bk_.y) * 16.f, 0u, false); \
    hq_[pj0] = (unsigned char)(hh_ & 0xffu); hq_[pj1] = (unsigned char)((hh_ >> 8) & 0xffu); \
    hq_[128 + pj0] = (unsigned char)(ll_ & 0xffu); hq_[128 + pj1] = (unsigned char)((ll_ >> 8) & 0xffu); } while (0)
#define V_TAB_DMA(KS, EV) do { _Pragma("unroll") for (int b_ = 4 * (KS); b_ < 4 * (KS) + 4; b_++) { \
      const unsigned e_ = (EV[b_ >> 3][(b_ >> 1) & 3] >> (16 * (b_ & 1))) & 0xffffu; const int pc_ = c8 ^ (g & 7) ^ (b_ & 1); \
      __builtin_amdgcn_global_load_lds((const unsigned*)(vts + (size_t)e_ * 128 + pc_ * 16), (LAS unsigned*)(img + b_ * 1024), 16, 0, 0); } } while (0)
#define V_TR(NB, KS) tr8_read(imgaddr + (4 * (KS) + q) * 1024 + tr_r * 128 + (((NB) ^ tr_r ^ ((4 * (KS) + q) & 1)) * 16) + tr_cc * 8)
  u32x4 evn[2], xoc, xon;
  V_META_DMA(0, V_TOK(0)); V_META_DMA(1, V_TOK(1));
  asm volatile("s_waitcnt vmcnt(0)" ::: "memory");
  V_STAGE(0, 0, evn, xoc);
  asm volatile("s_waitcnt lgkmcnt(0)" ::: "memory");
  V_TAB_DMA(0, evn); V_TAB_DMA(1, evn); V_TAB_DMA(2, evn); V_TAB_DMA(3, evn);
  asm volatile("s_waitcnt vmcnt(0)" ::: "memory");
  for (int it = 0; it < nit; it += 2) {
#pragma unroll
    for (int u = 0; u < 2; u++) {
      const int ii = it + u;
      if (ii < nit) {
        const int t = t0 + ii * stride;
        asm volatile("s_waitcnt vmcnt(18)" ::: "memory");
        V_STAGE(u ^ 1, u ^ 1, evn, xon);
        asm volatile("s_waitcnt lgkmcnt(0)" ::: "memory");
        __builtin_amdgcn_sched_barrier(0);
        V_META_DMA(u, V_TOK(ii + 2));
        f32x4 acc[8];
#pragma unroll
        for (int nb = 0; nb < 8; nb++) acc[nb] = (f32x4){0.f, 0.f, 0.f, 0.f};
        const int aoff = (n == 0) ? q * 8 : (n == 1) ? 128 + q * 8 : 512;
        long afr[2], bfr[2][8];
        asm volatile("s_waitcnt vmcnt(17)" ::: "memory");
        const int afaddr = (int)(uintptr_t)hqb + (n < 2 ? u * 256 : 0) + aoff, afstep = (n < 2 ? 32 : 0);
        afr[0] = lds_read64(afaddr);
#pragma unroll
        for (int nb = 0; nb < 8; nb++) bfr[0][nb] = V_TR(nb, 0);
#pragma unroll
        for (int ks = 0; ks < 4; ks++) {
          if (ks < 3) {
            if (ks == 0) asm volatile("s_waitcnt vmcnt(13)" ::: "memory"); else asm volatile("s_waitcnt vmcnt(9)" ::: "memory");
            afr[(ks + 1) & 1] = lds_read64(afaddr + (ks + 1) * afstep);
#pragma unroll
            for (int nb = 0; nb < 8; nb++) bfr[(ks + 1) & 1][nb] = V_TR(nb, ks + 1);
          }
          __builtin_amdgcn_sched_barrier(0);
          if (ks > 0) V_TAB_DMA(ks - 1, evn);
          if (ks < 3) asm volatile("s_waitcnt lgkmcnt(9)" ::: "memory"); else asm volatile("s_waitcnt lgkmcnt(0)" ::: "memory");
          __builtin_amdgcn_sched_barrier(0);
#pragma unroll
          for (int nb = 0; nb < 8; nb++) acc[nb] = __builtin_amdgcn_mfma_f32_16x16x32_fp8_fp8(afr[ks & 1], bfr[ks & 1][nb], acc[nb], 0, 0, 0);
          __builtin_amdgcn_sched_barrier(0);
        }
        V_TAB_DMA(3, evn);
        __builtin_amdgcn_sched_barrier(0);
        float xn[8]; float ss = 0.f;
#pragma unroll
        for (int nb = 0; nb < 8; nb++) {
          const float xv = (nb & 1) ? bfhi(xoc[nb >> 1]) : bflo(xoc[nb >> 1]);
          xn[nb] = xv + (acc[nb][0] + acc[nb][1] * (1.f / 16.f)) * (1.f / (SV * SH));
          ss += xn[nb] * xn[nb];
        }
        ss += __int_as_float(__builtin_amdgcn_update_dpp(0, __float_as_int(ss), 0x128, 0xf, 0xf, false));
        ss += __int_as_float(__builtin_amdgcn_update_dpp(0, __float_as_int(ss), 0x124, 0xf, 0xf, false));
        ss += __int_as_float(__builtin_amdgcn_update_dpp(0, __float_as_int(ss), 0x122, 0xf, 0xf, false));
        ss += __int_as_float(__builtin_amdgcn_update_dpp(0, __float_as_int(ss), 0x121, 0xf, 0xf, false));
        {
          if (q == 0) *(u32x4*)(xb + (size_t)t * DM + s * 128 + 8 * n) = (u32x4){pkbf(xn[0], xn[1]), pkbf(xn[2], xn[3]), pkbf(xn[4], xn[5]), pkbf(xn[6], xn[7])};
          if (lane == 0) ssq2[(size_t)t * 8 + s] = ss;
        }
        __builtin_amdgcn_sched_barrier(0);
        xoc = xon;
      }
    }
  }
  asm volatile("s_waitcnt vmcnt(0) lgkmcnt(0)" ::: "memory");
#undef V_TOK
#undef V_META_DMA
#undef V_STAGE
#undef V_TAB_DMA
#undef V_TR
}

struct EpiF32Scale {
  static constexpr bool PERM = false, AFTER_DRAIN = false;
  bf16_t* C; int ldc; const float* ssq2;
  __device__ __forceinline__ void operator()(const f32x4 (&acc)[2][2][4][2], const pg8::Unit& u, int wr, int wc, int fr, int fq) const {
    asm volatile("" : "+v"(fr), "+v"(fq));
    const int row0 = u.pm * 256 + wr * 64 + fr, col0 = u.pn * 256 + wc * 32 + 4 * fq;
    f32x4 s0[2][4], s1[2][4];
#pragma unroll
    for (int ai = 0; ai < 2; ++ai)
#pragma unroll
      for (int m = 0; m < 4; ++m) { const size_t row = (size_t)(row0 + ai * 128 + m * 16); s0[ai][m] = *(const f32x4*)(ssq2 + row * 8); s1[ai][m] = *(const f32x4*)(ssq2 + row * 8 + 4); }
    __builtin_amdgcn_sched_barrier(0);
#pragma unroll
    for (int ai = 0; ai < 2; ++ai)
#pragma unroll
      for (int m = 0; m < 4; ++m) {
        const int row = row0 + ai * 128 + m * 16;
        const f32x4 sv = s0[ai][m] + s1[ai][m];
        const float r = rsqrtf((sv[0] + sv[1] + sv[2] + sv[3]) * (1.f / DM) + EPS);
        bf16_t* rowp = C + (size_t)row * ldc + col0;
#pragma unroll
        for (int bj = 0; bj < 2; ++bj)
#pragma unroll
          for (int n = 0; n < 2; ++n) { const f32x4 v = acc[ai][bj][m][n] * r; u32x2 w; w.x = pkbf(v[0], v[1]); w.y = pkbf(v[2], v[3]); *(u32x2*)(rowp + bj * 128 + n * 16) = w; }
      }
  }
};

__device__ __forceinline__ void final_norm_phase(const Params& p) {
  const int tid = opaque_tid(), lane = tid & 63, wid = tid >> 6;
  const int gw = blockIdx.x * 8 + wid, nw = gridDim.x * 8;
  const float* ssq2 = (const float*)(p.ws + WS_SSQ2);
  const float* g = p.in[17];
  float* xr = p.out; const bf16_t* x4 = (const bf16_t*)(p.ws + WS_MISC + MS_X3B);
  f32x4 gv[4];
#pragma unroll
  for (int i = 0; i < 4; i++) gv[i] = *(const f32x4*)(g + lane * 16 + i * 4);
  for (int t0 = gw; t0 < T; t0 += 2 * nw) {
    u32x4 v[2][2]; f32x4 s0[2], s1[2];
#pragma unroll
    for (int k = 0; k < 2; k++) { const int t = (t0 + k * nw < T) ? (t0 + k * nw) : t0;
      s0[k] = *(const f32x4*)(ssq2 + (size_t)t * 8); s1[k] = *(const f32x4*)(ssq2 + (size_t)t * 8 + 4);
#pragma unroll
      for (int i = 0; i < 2; i++) v[k][i] = *(const u32x4*)(x4 + (size_t)t * DM + lane * 16 + i * 8); }
#pragma unroll
    for (int k = 0; k < 2; k++) {
      const int t = t0 + k * nw;
      const f32x4 sv = s0[k] + s1[k];
      const float r = rsqrtf((sv[0] + sv[1] + sv[2] + sv[3]) * (1.f / DM) + EPS);
      if (t < T) {
#pragma unroll
        for (int i = 0; i < 4; i++) { const unsigned wa = v[k][i >> 1][2 * (i & 1)], wb = v[k][i >> 1][2 * (i & 1) + 1];
          *(f32x4*)(xr + (size_t)t * DM + lane * 16 + i * 4) = (f32x4){bflo(wa), bfhi(wa), bflo(wb), bfhi(wb)} * r * gv[i]; }
      }
    }
  }
}

__device__ __forceinline__ void latnorm_phase(const Params& p) {
  const int tid = opaque_tid(), lane = tid & 63, wid = tid >> 6;
  const int gw = blockIdx.x * 8 + wid, nw = gridDim.x * 8;
  const bf16_t* lat = (const bf16_t*)(p.ws + WS_BIG + BG_LATQ);
  bf16_t* cq = (bf16_t*)(p.ws + WS_MISC + MS_CQ);
  bf16_t* ckv = (bf16_t*)(p.ws + WS_MISC + MS_CKV);
  bf16_t* kr = (bf16_t*)(p.ws + WS_MISC + MS_KR);
  const float* qn = p.in[7]; const float* kvn = p.in[8];
  const float* rc = (const float*)(p.ws + WS_ROPE); const float* rs = rc + 2048 * 16;
  float gq[6], gk[4];
#pragma unroll
  for (int i = 0; i < 6; i++) gq[i] = qn[lane * 6 + i];
#pragma unroll
  for (int i = 0; i < 4; i++) gk[i] = kvn[lane * 4 + i];
  for (int t0 = gw; t0 < T; t0 += 2 * nw) {
    float a[2][6]; f32x4 b[2]; float x1[2], x2[2];
#pragma unroll
    for (int k = 0; k < 2; k++) {
      const int t = (t0 + k * nw < T) ? (t0 + k * nw) : t0;
      const bf16_t* lr = lat + (size_t)t * 768;
#pragma unroll
      for (int i = 0; i < 3; i++) { const unsigned v = *(const unsigned*)(lr + lane * 6 + 2 * i); a[k][2 * i] = bflo(v); a[k][2 * i + 1] = bfhi(v); }
      { const u32x2 v = *(const u32x2*)(lr + 384 + lane * 4); b[k] = (f32x4){bflo(v.x), bfhi(v.x), bflo(v.y), bfhi(v.y)}; }
      x1[k] = bflo((unsigned)lr[640 + (lane & 15)]); x2[k] = bflo((unsigned)lr[656 + (lane & 15)]);
    }
#pragma unroll
    for (int k = 0; k < 2; k++) {
      const int t = t0 + k * nw;
      float s1 = 0.f, s2 = 0.f;
#pragma unroll
      for (int i = 0; i < 6; i++) s1 += a[k][i] * a[k][i];
      s2 = b[k][0] * b[k][0] + b[k][1] * b[k][1] + b[k][2] * b[k][2] + b[k][3] * b[k][3];
      s1 = wave_sum(s1); s2 = wave_sum(s2);
      const float r1 = rsqrtf(s1 * (1.f / 384.f) + EPS), r2 = rsqrtf(s2 * (1.f / 256.f) + EPS);
      if (t < T) {
        unsigned* cqp = (unsigned*)(cq + (size_t)t * 384 + lane * 6);
#pragma unroll
        for (int i = 0; i < 3; i++) cqp[i] = pkbf(a[k][2 * i] * r1 * gq[2 * i], a[k][2 * i + 1] * r1 * gq[2 * i + 1]);
        u32x2 w; w.x = pkbf(b[k][0] * r2 * gk[0], b[k][1] * r2 * gk[1]); w.y = pkbf(b[k][2] * r2 * gk[2], b[k][3] * r2 * gk[3]);
        *(u32x2*)(ckv + (size_t)t * 256 + lane * 4) = w;
        if (lane < 16) {
          const int pos = t & (SEQ - 1);
          const float c = rc[pos * 16 + lane], sn = rs[pos * 16 + lane];
          const unsigned o1 = pkbf(x1[k] * c - x2[k] * sn, 0.f), o2 = pkbf(x2[k] * c + x1[k] * sn, 0.f);
          kr[(size_t)t * 32 + lane] = (bf16_t)(o1 & 0xffffu);
          kr[(size_t)t * 32 + 16 + lane] = (bf16_t)(o2 & 0xffffu);
        }
      }
    }
  }
}

namespace att {
using f32x16 = __attribute__((ext_vector_type(16))) float;
using s16x4 = __attribute__((ext_vector_type(4))) short;
constexpr int NW = 8, QBLK = 32, KVBLK = 64;
constexpr float SCALE = 0.10206207261596575f;
constexpr float THR = 8.f;
constexpr int LDQ = 1536, LDKV = 2048, LDR = 32, LDO = 1024;
constexpr int SHM_V = KVBLK * 128 * 2, SHM_K = KVBLK * 128 * 2;
#define KSWZ(row, colB) ((row) * 256 + ((colB) ^ (((row) & 7) << 4)))
#define SBAR() __builtin_amdgcn_sched_barrier(0)
__device__ __forceinline__ int crow(int r, int hi) { return (r & 3) + 8 * (r >> 2) + 4 * hi; }
__device__ __forceinline__ unsigned cvtpk(float lo, float hi) { unsigned r; asm volatile("v_cvt_pk_bf16_f32 %0, %1, %2" : "=v"(r) : "v"(lo), "v"(hi)); return r; }

__device__ __forceinline__ void partialSM(f32x16& p0, f32x16& p1, float& m_reg, float& mn, float& alpha) {
  constexpr float C = SCALE * 1.4426950408889634f;
  float pmax = p0[0];
#pragma unroll
  for (int r = 1; r < 16; ++r) pmax = fmaxf(pmax, p0[r]);
#pragma unroll
  for (int r = 0; r < 16; ++r) pmax = fmaxf(pmax, p1[r]);
  { auto rr = __builtin_amdgcn_permlane32_swap(__float_as_uint(pmax), __float_as_uint(pmax), false, false);
    pmax = fmaxf(__uint_as_float(rr[0]), __uint_as_float(rr[1])); }
  if (__builtin_expect(__all(pmax - m_reg <= THR / SCALE), 1)) { mn = m_reg; alpha = 1.f; }
  else { mn = fmaxf(m_reg, pmax); alpha = __builtin_amdgcn_exp2f((m_reg - mn) * C); m_reg = mn; }
  const float mnC = -mn * C;
#pragma unroll
  for (int r = 0; r < 16; ++r) p0[r] = fmaf(p0[r], C, mnC);
#pragma unroll
  for (int r = 0; r < 16; ++r) p1[r] = fmaf(p1[r], C, mnC);
#pragma unroll
  for (int r = 0; r < 16; ++r) p0[r] = __builtin_amdgcn_exp2f(p0[r]);
}
__device__ __forceinline__ void finishSM(f32x16& p0, f32x16& p1, float alpha, float& l_reg, bf16x8& pa0, bf16x8& pa1, bf16x8& pa2, bf16x8& pa3) {
#pragma unroll
  for (int r = 0; r < 16; ++r) p1[r] = __builtin_amdgcn_exp2f(p1[r]);
  float ps = 0;
#pragma unroll
  for (int r = 0; r < 16; ++r) ps += p0[r];
#pragma unroll
  for (int r = 0; r < 16; ++r) ps += p1[r];
  { auto rr = __builtin_amdgcn_permlane32_swap(__float_as_uint(ps), __float_as_uint(ps), false, false);
    ps = __uint_as_float(rr[0]) + __uint_as_float(rr[1]); }
  l_reg = l_reg * alpha + ps;
#define PK4(P, BASE, OUT) do { unsigned a0 = cvtpk(P[BASE + 0], P[BASE + 1]), a1 = cvtpk(P[BASE + 2], P[BASE + 3]);   \
    unsigned b0 = cvtpk(P[BASE + 4], P[BASE + 5]), b1 = cvtpk(P[BASE + 6], P[BASE + 7]);                              \
    auto r0 = __builtin_amdgcn_permlane32_swap(a0, b0, false, false); auto r1 = __builtin_amdgcn_permlane32_swap(a1, b1, false, false); \
    u32x4 w = {r0[0], r1[0], r0[1], r1[1]}; OUT = *reinterpret_cast<bf16x8*>(&w); } while (0)
  PK4(p0, 0, pa0); PK4(p0, 8, pa1); PK4(p1, 0, pa2); PK4(p1, 8, pa3);
#undef PK4
}
__device__ __forceinline__ void qkt(f32x16& p0, f32x16& p1, const LAS unsigned char* Ks, const bf16x8* qr, int r32, int hi) {
  p0 = f32x16{}; p1 = f32x16{};
#pragma unroll
  for (int d0 = 0; d0 < 6; ++d0) { const int cb = (d0 * 16 + hi * 8) * 2;
    const bf16x8 b0 = *reinterpret_cast<const LAS bf16x8*>(Ks + KSWZ(r32, cb));
    const bf16x8 b1 = *reinterpret_cast<const LAS bf16x8*>(Ks + KSWZ(32 + r32, cb));
    p0 = __builtin_amdgcn_mfma_f32_32x32x16_bf16(b0, qr[d0], p0, 0, 0, 0);
    p1 = __builtin_amdgcn_mfma_f32_32x32x16_bf16(b1, qr[d0], p1, 0, 0, 0); }
}
__device__ __forceinline__ int v_st(int k, int c) { const int kk = (k & ~0xC) | ((k & 4) << 1) | ((k & 8) >> 1); return ((kk >> 3) * 4 + (c >> 5)) * 512 + ((kk & 7) * 32 + (c & 31)) * 2; }
__device__ __forceinline__ int v_rd_base(int lane) { return ((lane & 3) << 3) | (((lane >> 2) & 3) << 6) | (((lane >> 4) & 1) << 5) | (((lane >> 5) & 1) << 8); }
constexpr int v_rd_off(int d0, int ks, int half) { return d0 * 512 + ks * 4096 + half * 2048; }
template <int OFF> __device__ __forceinline__ s16x4 tr_read(int vb) {
  s16x4 r; asm volatile("ds_read_b64_tr_b16 %0, %1 offset:%2" : "=&v"(r) : "v"(vb), "i"(OFF) : "memory"); return r;
}
template <int D0> __device__ __forceinline__ void pv_one(f32x16& od, int vb, bf16x8 pa0, bf16x8 pa1, bf16x8 pa2, bf16x8 pa3) {
  const s16x4 l0 = tr_read<v_rd_off(D0, 0, 0)>(vb), h0 = tr_read<v_rd_off(D0, 0, 1)>(vb), l1 = tr_read<v_rd_off(D0, 1, 0)>(vb), h1 = tr_read<v_rd_off(D0, 1, 1)>(vb);
  const s16x4 l2 = tr_read<v_rd_off(D0, 2, 0)>(vb), h2 = tr_read<v_rd_off(D0, 2, 1)>(vb), l3 = tr_read<v_rd_off(D0, 3, 0)>(vb), h3 = tr_read<v_rd_off(D0, 3, 1)>(vb);
  asm volatile("s_waitcnt lgkmcnt(0)" ::: "memory"); SBAR();
#define PK(L, H) (bf16x8){L[0], L[1], L[2], L[3], H[0], H[1], H[2], H[3]}
  od = __builtin_amdgcn_mfma_f32_32x32x16_bf16(pa0, PK(l0, h0), od, 0, 0, 0);
  od = __builtin_amdgcn_mfma_f32_32x32x16_bf16(pa1, PK(l1, h1), od, 0, 0, 0);
  od = __builtin_amdgcn_mfma_f32_32x32x16_bf16(pa2, PK(l2, h2), od, 0, 0, 0);
  od = __builtin_amdgcn_mfma_f32_32x32x16_bf16(pa3, PK(l3, h3), od, 0, 0, 0);
#undef PK
}
__device__ __forceinline__ void pv_d0(f32x16* o, int vb, bf16x8 pa0, bf16x8 pa1, bf16x8 pa2, bf16x8 pa3) {
  pv_one<0>(o[0], vb, pa0, pa1, pa2, pa3); pv_one<1>(o[1], vb, pa0, pa1, pa2, pa3);
}

__device__ __forceinline__ void attn_body(const bf16_t* __restrict__ Qb, const bf16_t* __restrict__ KVh, const bf16_t* __restrict__ KRb,
                                          bf16_t* __restrict__ Ob, int seq, LAS unsigned char* lds) {
  const int tid = opaque_tid(), wid = tid >> 6, lane = tid & 63, r32 = lane & 31, hi = lane >> 5;
  LAS unsigned char* V_lds = lds; LAS unsigned char* K_lds = lds + 2 * SHM_V;
  LAS float* wsf = (LAS float*)(lds + 2 * SHM_V + 2 * SHM_K) + wid * 64; LAS float* li_l = wsf; LAS float* al_l = wsf + 32;
  float m_reg = -1e30f, l_reg = 0; f32x16 o[2] = {}; bf16x8 qr[6];
  const bf16_t* Qw = Qb + (long)(wid * QBLK + r32) * LDQ + hi * 8;
#pragma unroll
  for (int d0 = 0; d0 < 6; ++d0) qr[d0] = *reinterpret_cast<const bf16x8*>(Qw + d0 * 16);
  const int sr = tid >> 4, sc = (tid & 15) * 8, vst0 = v_st(sr, sc), vst1 = v_st(32 + sr, sc);
  const bool kval = sc < 96, vval = sc < 64;
  const bf16_t* kbase = (sc < 64) ? (KVh + sc) : (KRb + (sc - 64));
  const long kstr = (sc < 64) ? LDKV : LDR;
  const bf16_t* vbase = KVh + 64 + sc;
  const int vb0 = (int)(uintptr_t)V_lds + v_rd_base(lane);
  struct { bf16x8 vs0, vs1, ks0, ks1; } sr_[2];
  const bf16x8 zero8 = {0, 0, 0, 0, 0, 0, 0, 0};
#define SLOAD(i, k0) do { sr_[i].vs0 = vval ? *reinterpret_cast<const bf16x8*>(vbase + (long)((k0) + sr) * LDKV) : zero8; \
    sr_[i].vs1 = vval ? *reinterpret_cast<const bf16x8*>(vbase + (long)((k0) + 32 + sr) * LDKV) : zero8; \
    sr_[i].ks0 = kval ? *reinterpret_cast<const bf16x8*>(kbase + (long)((k0) + sr) * kstr) : zero8; \
    sr_[i].ks1 = kval ? *reinterpret_cast<const bf16x8*>(kbase + (long)((k0) + 32 + sr) * kstr) : zero8; } while (0)
#define SWRITE(b, i) do { if (vval) { *(LAS bf16x8*)(V_lds + (b) * SHM_V + vst0) = sr_[i].vs0;          \
    *(LAS bf16x8*)(V_lds + (b) * SHM_V + vst1) = sr_[i].vs1; } const int kc = sc * 2;               \
    if (kval) { *(LAS bf16x8*)(K_lds + (b) * SHM_K + KSWZ(sr, kc)) = sr_[i].ks0;                       \
    *(LAS bf16x8*)(K_lds + (b) * SHM_K + KSWZ(32 + sr, kc)) = sr_[i].ks1; } } while (0)
#define SWAIT() asm volatile("s_waitcnt vmcnt(4)" ::: "memory")
#define RESC(a) do { if (__any((a) < 1.f)) { if (hi == 0) al_l[r32] = (a); asm volatile("s_waitcnt lgkmcnt(0)" ::: "memory"); \
    _Pragma("unroll") for (int d = 0; d < 2; ++d) _Pragma("unroll") for (int r = 0; r < 16; ++r) o[d][r] *= al_l[crow(r, hi)]; } } while (0)
  f32x16 pA0, pA1, pB0, pB1; float mnA, mnB, alA, alB; bf16x8 pa0, pa1, pa2, pa3; const int NT = seq / KVBLK;
  constexpr int SE = 0, SO = 1;
  SLOAD(SE, 0); asm volatile("s_waitcnt vmcnt(0)" ::: "memory"); SWRITE(0, SE); __syncthreads();
  qkt(pA0, pA1, K_lds, qr, r32, hi); partialSM(pA0, pA1, m_reg, mnA, alA);
  SLOAD(SO, KVBLK); if (2 < NT) SLOAD(SE, 2 * KVBLK);
  SWAIT(); SWRITE(1, SO); __syncthreads();
  for (int j = 1; j + 1 < NT; j += 2) {
    SBAR(); qkt(pB0, pB1, K_lds + SHM_K, qr, r32, hi);
    finishSM(pA0, pA1, alA, l_reg, pa0, pa1, pa2, pa3); SBAR();
    SLOAD(SO, (j + 2) * KVBLK); SBAR();
    pv_d0(o, vb0, pa0, pa1, pa2, pa3); partialSM(pB0, pB1, m_reg, mnB, alB);
    __syncthreads(); SWAIT(); SWRITE(0, SE);
    RESC(alB); __syncthreads();
    SBAR(); qkt(pA0, pA1, K_lds, qr, r32, hi);
    finishSM(pB0, pB1, alB, l_reg, pa0, pa1, pa2, pa3); SBAR();
    if (j + 3 < NT) SLOAD(SE, (j + 3) * KVBLK); SBAR();
    pv_d0(o, vb0 + SHM_V, pa0, pa1, pa2, pa3); partialSM(pA0, pA1, m_reg, mnA, alA);
    __syncthreads(); SWAIT(); SWRITE(1, SO);
    RESC(alA); __syncthreads();
  }
  SBAR(); qkt(pB0, pB1, K_lds + SHM_K, qr, r32, hi);
  finishSM(pA0, pA1, alA, l_reg, pa0, pa1, pa2, pa3); SBAR();
  pv_d0(o, vb0, pa0, pa1, pa2, pa3); partialSM(pB0, pB1, m_reg, mnB, alB);
  __syncthreads(); RESC(alB);
  finishSM(pB0, pB1, alB, l_reg, pa0, pa1, pa2, pa3); SBAR();
  pv_d0(o, vb0 + SHM_V, pa0, pa1, pa2, pa3);
  if (hi == 0) li_l[r32] = l_reg; asm volatile("s_waitcnt lgkmcnt(0)" ::: "memory");
  float rli[16];
#pragma unroll
  for (int r = 0; r < 16; ++r) rli[r] = __builtin_amdgcn_rcpf(li_l[crow(r, hi)]);
  bf16_t* Ow = Ob + (long)(wid * QBLK) * LDO;
#pragma unroll
  for (int r = 0; r < 16; ++r) { const int orow = crow(r, hi);
#pragma unroll
    for (int d0 = 0; d0 < 2; ++d0) Ow[(long)orow * LDO + d0 * 32 + r32] = (bf16_t)(cvtpk(o[d0][r] * rli[r], 0.f) & 0xffffu); }
  __syncthreads();
#undef SLOAD
#undef SWRITE
#undef SWAIT
#undef RESC
}
#undef KSWZ
#undef SBAR
}

__device__ __forceinline__ void attn_phase(const Params& p, LAS unsigned char* lds) {
  const bf16_t* Q = (const bf16_t*)(p.ws + WS_BIG + BG_LATQ);
  const bf16_t* KV = (const bf16_t*)(p.ws + WS_BIG + BG_KV);
  const bf16_t* KR = (const bf16_t*)(p.ws + WS_MISC + MS_KR);
  bf16_t* O = (bf16_t*)p.out;
  for (int it = blockIdx.x; it < 4096; it += gridDim.x) {
    const int rnd = it >> 8, cc = it & 255;
    const int pair = rnd * 32 + (cc & 7) * 4 + ((cc >> 3) >> 3), qb = (cc >> 3) & 7;
    const int b = pair >> 4, h = pair & 15;
    const size_t tok0 = (size_t)b * SEQ;
    att::attn_body(Q + (tok0 + qb * 256) * 1536 + h * 96, KV + tok0 * 2048 + h * 128, KR + tok0 * 32,
                   O + (tok0 + qb * 256) * 1024 + h * 64, SEQ, lds);
  }
}

constexpr int NPH = 19;
#ifndef PHM
#define PHM 0xfffff
#endif
__global__ void __launch_bounds__(512, 2) mega_fwd(Params p) {
  extern __shared__ __attribute__((aligned(16))) unsigned char lds_raw[];
  LAS unsigned char* lds = (LAS unsigned char*)lds_raw;
  cg::grid_group grid = cg::this_grid();
  volatile LAS unsigned* bst = (volatile LAS unsigned*)(lds + LDS_BYTES - 16);
  if (threadIdx.x == 0) { bst[0] = 0u; bst[1] = 0u; }
  __syncthreads();
  XcdBarrier xbar = xcd_barrier_post((unsigned*)(p.ws + WS_BAR), bst);
  volatile LAS unsigned* shw = (volatile LAS unsigned*)(lds + LDS_BYTES - 32);
  if (threadIdx.x == 0) { const unsigned x = xb_xcc_id() & 7u; shw[0] = x; shw[1] = atomicAdd((unsigned*)(p.ws + WS_BAR) + 3500 + 64 * x, 1u); }
  __syncthreads();
  pg8::StaticOrder S;
#ifdef PROBE_A
  unsigned long long* stamps = (unsigned long long*)(p.ws + WS_END);
  if (blockIdx.x == 0 && threadIdx.x == 0) stamps[0] = __builtin_amdgcn_s_memrealtime();
#endif
  int repeated = 0; (void)repeated;
  for (int ph = p.ph_lo; ph < p.ph_hi; ++ph) {
    __attribute__((address_space(1))) unsigned char* wsg = (__attribute__((address_space(1))) unsigned char*)p.ws; asm volatile("" : "+s"(wsg));
    unsigned char* ws = (unsigned char*)wsg;
    const int l = (ph >= 13) ? 1 : 0;
    switch (ph) {
      case 0: if (PHM & 1) prep_phase(p, lds); break;
      case 1: if (PHM & 2) {
        pg8::Gemm g{(const bf16_t*)(ws + WS_XB), (const bf16_t*)(ws + WS_BT1), T, 3072, 1024};
        S.init(g.M, g.N, (int)gridDim.x, (int)blockIdx.x);
        EpiConv E{(bf16_t*)(ws + WS_BIG + BG_BB), (bf16_t*)(ws + WS_BIG + BG_UB)};
        pg8::gemm_phase<EpiConv, pg8::StaticOrder, false>(lds, g, S, E, nullptr);
      } break;
      case 2: if (PHM & 4) convz_phase(p); break;
      case 3: case 13: if (PHM & 8) {
        const bool first = (ph == 3);
        pg8::Gemm g{first ? (const bf16_t*)(ws + WS_BIG + BG_BB) : (const bf16_t*)p.out, first ? (const bf16_t*)(ws + WS_BT2) : (const bf16_t*)(ws + WS_BT9), T, 1024, 1024};
        S.init(g.M, g.N, (int)gridDim.x, (int)blockIdx.x);
        if (first) { EpiResid<false> E{(const void*)p.in[0], (bf16_t*)(ws + WS_XB), (float*)(ws + WS_SSQ)}; pg8::gemm_phase<EpiResid<false>, pg8::StaticOrder, false>(lds, g, S, E, nullptr); }
        else { EpiResid<true> E{(const void*)(ws + WS_XB), (bf16_t*)(ws + WS_MISC + MS_X3B), (float*)(ws + WS_SSQ)}; pg8::gemm_phase<EpiResid<true>, pg8::StaticOrder, false>(lds, g, S, E, nullptr); }
      } break;
      case 4: case 14: if (PHM & 16) {
        pg8::Gemm g{l ? (const bf16_t*)(ws + WS_MISC + MS_X3B) : (const bf16_t*)(ws + WS_XB), (const bf16_t*)(ws + WS_BT3) + (size_t)l * 2048 * 1024, T, 2048, 1024};
        S.init(g.M, g.N, (int)gridDim.x, (int)blockIdx.x);
        pg8::EpiBf16<0> E{(bf16_t*)(ws + WS_BIG + BG_SCORES), 2048, nullptr, 0, 0};
        pg8::gemm_phase<pg8::EpiBf16<0>, pg8::StaticOrder, false>(lds, g, S, E, nullptr);
      } break;
      case 5: case 15: if (PHM & 32) topk_phase(p, lds, l); break;
      case 6: case 16: if (PHM & 64) {
#ifdef REPEAT_U
        for (int rep = 0; rep < 2; ++rep) { int uv = rep ? REPEAT_U : 0; asm volatile("" : "+s"(uv)); if (rep) xcd_barrier(xbar); peer_u_phase(p, l, lds, uv); }
#else
        peer_u_phase(p, l, lds, 0);
#endif
      } break;
      case 7: case 17: if (PHM & 4096) { peer_v_phase(p, l, lds);
#ifdef REPEAT_V
        xcd_barrier(xbar); peer_v_phase(p, l, lds, 1);
#endif
      } break;
      case 8: if (PHM & 128) {
        pg8::Gemm g{(const bf16_t*)(ws + WS_XB), (const bf16_t*)(ws + WS_BT5), T, 768, 1024};
        S.init(g.M, g.N, (int)gridDim.x, (int)blockIdx.x);
        EpiF32Scale E{(bf16_t*)(ws + WS_BIG + BG_LATQ), 768, (const float*)(ws + WS_SSQ2)};
        pg8::gemm_phase<EpiF32Scale, pg8::StaticOrder, false>(lds, g, S, E, nullptr);
      } break;
      case 9: if (PHM & 256) latnorm_phase(p); break;
      case 10: if (PHM & 512) {
        pg8::Gemm g{(const bf16_t*)(ws + WS_MISC + MS_CQ), (const bf16_t*)(ws + WS_BT6), T, 1536, 384};
        S.init(g.M, g.N, (int)gridDim.x, (int)blockIdx.x);
        EpiQ E{(bf16_t*)(ws + WS_BIG + BG_LATQ), (const float*)(ws + WS_ROPE), (const float*)(ws + WS_ROPE) + 2048 * 16};
        pg8::gemm_phase<EpiQ, pg8::StaticOrder, false>(lds, g, S, E, nullptr);
      } break;
      case 11: if (PHM & 2048) {
        pg8::Gemm g{(const bf16_t*)(ws + WS_MISC + MS_CKV), (const bf16_t*)(ws + WS_BT7), T, 2048, 256};
        S.init(g.M, g.N, (int)gridDim.x, (int)blockIdx.x);
        pg8::EpiBf16<0> E{(bf16_t*)(ws + WS_BIG + BG_KV), 2048, nullptr, 0, 0};
        pg8::gemm_phase<pg8::EpiBf16<0>, pg8::StaticOrder, false>(lds, g, S, E, nullptr);
      } break;
      case 12: if (PHM & 1024) attn_phase(p, lds); break;
      case 18: if (PHM & 8192) final_norm_phase(p); break;
      default: break;
    }
#ifdef PROBE_A
    grid.sync();
    if (blockIdx.x == 0 && threadIdx.x == 0) stamps[ph + 1] = __builtin_amdgcn_s_memrealtime();
#else
#ifdef REPEAT_PH
    if (ph == REPEAT_PH && !repeated) { repeated = 1; xcd_barrier(xbar); --ph; continue; }
#endif
    if (ph + 1 < p.ph_hi) { if (ph == 10) __syncthreads(); else if (ph == 0) grid.sync(); else xcd_barrier(xbar); }
#endif
  }
#ifdef PROBE_A
  __threadfence(); grid.sync();
  {
    const volatile unsigned long long* st = stamps;
    const float qa = exp2f(rintf(log2f((float)(st[PROBE_A + 1] - st[PROBE_A]) * 0.01f) * PROBE_Q) * (1.0f / PROBE_Q));
    const float qb = exp2f(rintf(log2f((float)(st[PROBE_B + 1] - st[PROBE_B]) * 0.01f) * PROBE_Q) * (1.0f / PROBE_Q));
    const float ka = qa / (float)PROBE_KDIV;
    const float vb = qb / (float)PROBE_VDIV;
    for (size_t i = (size_t)blockIdx.x * 512 + threadIdx.x; i < (size_t)T * DM; i += (size_t)gridDim.x * 512) p.out[i] = (i == 0) ? vb : ka;
  }
#endif
}

#ifndef MK_SPLIT
#define MK_SPLIT 0
#endif
extern "C" void kernel_launch(void* const* d_in, const int* in_sizes, int n_in, void* d_out, int out_size, void* d_ws, size_t ws_size, hipStream_t stream) {
  static int grid = 0;
  if (grid == 0) {
    if (n_in != 18 || out_size != T * DM || ws_size < WS_END) { fprintf(stderr, "kernel_launch: unexpected shapes (n_in %d out %d ws %zu need %zu)\n", n_in, out_size, ws_size, (size_t)WS_END); grid = -1; return; }
    int dev = 0, cus = 0, per_cu = 0;
    if (hipGetDevice(&dev) != hipSuccess || hipDeviceGetAttribute(&cus, hipDeviceAttributeMultiprocessorCount, dev) != hipSuccess) { grid = -1; return; }
    if (hipFuncSetAttribute((const void*)mega_fwd, hipFuncAttributeMaxDynamicSharedMemorySize, LDS_BYTES) != hipSuccess) { fprintf(stderr, "kernel_launch: hipFuncSetAttribute failed\n"); grid = -1; return; }
    if (hipOccupancyMaxActiveBlocksPerMultiprocessor(&per_cu, (const void*)mega_fwd, 512, LDS_BYTES) != hipSuccess || per_cu < 1) { fprintf(stderr, "kernel_launch: occupancy query failed (%d)\n", per_cu); grid = -1; return; }
    if (cus < 8 || (cus % 8) != 0) { fprintf(stderr, "kernel_launch: CU count %d is not a multiple of 8\n", cus); grid = -1; return; }
    grid = cus * 1;
  }
  if (grid < 0) return;
  Params p{};
  for (int i = 0; i < 18; ++i) p.in[i] = (const float*)d_in[i];
  p.out = (float*)d_out; p.ws = (unsigned char*)d_ws;
  (void)hipMemsetAsync((unsigned char*)d_ws + WS_BAR, 0, (size_t)XCD_BAR_WORDS * 4 + 4096, stream);
#if MK_SPLIT
  for (int ph = 0; ph < NPH; ++ph) {
    p.ph_lo = ph; p.ph_hi = ph + 1;
    void* args[] = {&p};
    hipError_t e = hipLaunchCooperativeKernel((const void*)mega_fwd, dim3(grid), dim3(512), args, LDS_BYTES, stream);
    if (e != hipSuccess) fprintf(stderr, "launch failed: %s\n", hipGetErrorString(e));
  }
#else
  p.ph_lo = 0; p.ph_hi = NPH;
  void* args[] = {&p};
  hipError_t e = hipLaunchCooperativeKernel((const void*)mega_fwd, dim3(grid), dim3(512), args, LDS_BYTES, stream);
  if (e != hipSuccess) fprintf(stderr, "cooperative launch failed: %s (grid %d)\n", hipGetErrorString(e), grid);
#endif
}
```

```cpp
#include <hip/hip_runtime.h>
#include <hip/hip_cooperative_groups.h>
#include <stdint.h>
#include <math.h>
#include <cstdio>
namespace cg = cooperative_groups;

__device__ __forceinline__ int opaque_tid() { int t = threadIdx.x; asm volatile("" : "+v"(t)); return t; }
namespace pg8 {
#define PG8_LAS __attribute__((address_space(3)))
typedef unsigned short bf16_t;
typedef short bf16x8 __attribute__((ext_vector_type(8)));
typedef float f32x4 __attribute__((ext_vector_type(4)));
typedef unsigned u32x4 __attribute__((ext_vector_type(4)));
constexpr int BM = 256, BK = 64, HALF = 128, HTB = HALF * BK * 2  , STAGE_BYTES = 8 * HTB, NXCD = 8, WGM = 8;

__host__ __device__ __forceinline__ int lds_byte(int r, int c) { const int st = (r >> 4) * 2 + (c >> 5), rr = r & 15, cc = c & 31, ob = rr * 64 + cc * 2; return st * 1024 + (ob ^ (((ob >> 9) & 1) << 5)); }
__host__ __device__ __forceinline__ void stage_rc(int b, int& R, int& C) { const int st = b / 1024, sb = b % 1024, swz = sb ^ (((sb >> 9) & 1) << 5); R = (st >> 1) * 16 + swz / 64; C = (st & 1) * 32 + (swz % 64) / 2; }
__host__ __device__ __forceinline__ int perm32(int rho) { const int n = rho >> 4, i = rho & 15; return 8 * (i >> 2) + 4 * n + (i & 3); }

struct Unit { int pm, pn; };
struct Gemm { const bf16_t* A; const bf16_t* Bt; int M, N, K; };

struct StaticOrder {
    int nM, nN, nwg, G, c;
    __host__ __device__ void init(int M, int N, int G_, int c_) { nM = M / BM; nN = N / BM; nwg = nM * nN; G = G_; c = c_; }
    __host__ __device__ bool next(int i, Unit& u) const {
        const long L = (long)i * G + c; if (L >= nwg) return false;
        int wgid = (int)L; { const int q = nwg / NXCD, r = nwg % NXCD, xcd = wgid % NXCD, off = wgid / NXCD; wgid = (xcd < r ? xcd * (q + 1) : r * (q + 1) + (xcd - r) * q) + off; }
        const int nig = WGM * nN, gid = wgid / nig, fm = gid * WGM, gsz = (nM - fm) < WGM ? (nM - fm) : WGM;
        u.pm = fm + ((wgid % nig) % gsz); u.pn = (wgid % nig) / gsz; return true;
    }
    __device__ __forceinline__ void a_ready(const Unit&) const {}
    __device__ __forceinline__ void done(const Unit&) const {}
};
__device__ __forceinline__ unsigned cvt_pk_bf16(float lo, float hi) { unsigned r; asm volatile("v_cvt_pk_bf16_f32 %0, %1, %2" : "=v"(r) : "v"(lo), "v"(hi)); return r; }
typedef float f32x2 __attribute__((ext_vector_type(2)));
__device__ __forceinline__ f32x2 gelu_pk(f32x2 v) {
    const f32x2 av = __builtin_elementwise_abs(v), d = av * 0.2316418882f + 1.0f;
    f32x2 t; t.x = __builtin_amdgcn_rcpf(d.x); t.y = __builtin_amdgcn_rcpf(d.y);
    f32x2 q = t * 0.5307027145f + (-0.7265760135f); q = q * t + 0.7107068705f; q = q * t + (-0.142248368f); q = q * t + 0.127414796f; q = q * t;
    const f32x2 s = (v * v) * (-0.72134752044f);
    f32x2 e; e.x = __builtin_amdgcn_exp2f(s.x); e.y = __builtin_amdgcn_exp2f(s.y);
    const f32x2 m = v * (q * e), r = v - m;
    f32x2 o; o.x = v.x < 0.f ? m.x : r.x; o.y = v.y < 0.f ? m.y : r.y; return o;
}

struct EpiF32 {
    static constexpr bool PERM = false, AFTER_DRAIN = false;
    float* C; int ldc; const float* bias;
    __device__ __forceinline__ void operator()(const f32x4 (&acc)[2][2][4][2], const Unit& u, int wr, int wc, int fr, int fq) const {
        asm volatile("" : "+v"(fr), "+v"(fq));
        const int row0 = u.pm * BM + wr * 64 + fr, col0 = u.pn * BM + wc * 32 + 4 * fq;
        f32x4 bv[2][2];
#pragma unroll
        for (int bj = 0; bj < 2; ++bj)
#pragma unroll
            for (int n = 0; n < 2; ++n) bv[bj][n] = bias ? *(const f32x4*)(bias + col0 + bj * HALF + n * 16) : (f32x4){0.f, 0.f, 0.f, 0.f};
#pragma unroll
        for (int ai = 0; ai < 2; ++ai)
#pragma unroll
            for (int m = 0; m < 4; ++m) { float* rowp = C + (size_t)(row0 + ai * HALF + m * 16) * ldc + col0;
#pragma unroll
                for (int bj = 0; bj < 2; ++bj)
#pragma unroll
                    for (int n = 0; n < 2; ++n) *(f32x4*)(rowp + bj * HALF + n * 16) = acc[ai][bj][m][n] + bv[bj][n]; }
    }
};
template <int ACT  > struct EpiBf16 {
    static constexpr bool PERM = true, AFTER_DRAIN = false;
    bf16_t* O; int ldc; const float* bias; int split_cols; size_t split_stride;
    __device__ __forceinline__ void operator()(const f32x4 (&acc)[2][2][4][2], const Unit& u, int wr, int wc, int fr, int fq) const {
        asm volatile("" : "+v"(fr), "+v"(fq));
        const int row0 = u.pm * BM + wr * 64 + fr; int colt = u.pn * BM; bf16_t* base = O;
        if (split_cols) { const int t = colt / split_cols; base += (size_t)t * split_stride; colt -= t * split_cols; }
        const int col0 = colt + wc * 32 + 8 * fq, bcol0 = u.pn * BM + wc * 32 + 8 * fq;
        f32x4 bv[2][2];
#pragma unroll
        for (int bj = 0; bj < 2; ++bj)
#pragma unroll
            for (int n = 0; n < 2; ++n) bv[bj][n] = bias ? *(const f32x4*)(bias + bcol0 + bj * HALF + 4 * n) : (f32x4){0.f, 0.f, 0.f, 0.f};
#pragma unroll
        for (int ai = 0; ai < 2; ++ai)
#pragma unroll
            for (int m = 0; m < 4; ++m) { bf16_t* rowp = base + (size_t)(row0 + ai * HALF + m * 16) * ldc + col0;
#pragma unroll
                for (int bj = 0; bj < 2; ++bj) { f32x4 v0 = acc[ai][bj][m][0] + bv[bj][0], v1 = acc[ai][bj][m][1] + bv[bj][1];
                    if (ACT == 1) { f32x2 a = gelu_pk((f32x2){v0[0], v0[1]}), b = gelu_pk((f32x2){v0[2], v0[3]}), c = gelu_pk((f32x2){v1[0], v1[1]}), d = gelu_pk((f32x2){v1[2], v1[3]});
                        v0 = (f32x4){a.x, a.y, b.x, b.y}; v1 = (f32x4){c.x, c.y, d.x, d.y}; }
                    if (ACT == 2) {
#pragma unroll
                        for (int j = 0; j < 4; ++j) { v0[j] = 0.5f * v0[j] * (1.0f + erff(v0[j] * 0.70710678f)); v1[j] = 0.5f * v1[j] * (1.0f + erff(v1[j] * 0.70710678f)); } }
                    u32x4 w; w.x = cvt_pk_bf16(v0[0], v0[1]); w.y = cvt_pk_bf16(v0[2], v0[3]); w.z = cvt_pk_bf16(v1[0], v1[1]); w.w = cvt_pk_bf16(v1[2], v1[3]);
                    *(u32x4*)(rowp + bj * HALF) = w; } }
    }
};
template <class Epi, class Sched, bool STAMP = false>
__device__ __forceinline__ void gemm_phase(PG8_LAS unsigned char* lds, const Gemm g, const Sched& S, const Epi& E, unsigned long long* stamps) {
    const int tid = opaque_tid(), wid = __builtin_amdgcn_readfirstlane(tid >> 6), lane = tid & 63, wr = wid >> 2, wc = wid & 3, fr = lane & 15, fq = lane >> 4;
    int K = g.K; asm volatile("" : "+s"(K));
    const int nt = K / BK;
    int ts_lo = 0, ts_hi = 0, nts = 0; const unsigned long long rt_entry = STAMP ? (unsigned long long)wall_clock64() : 0ull;
#define PG8_STAMP() do { if (STAMP && wid == 0 && nts < 64) { const unsigned long long _c = (unsigned long long)clock64(); \
        ts_lo = (lane == nts) ? (int)(unsigned)_c : ts_lo; ts_hi = (lane == nts) ? (int)(unsigned)(_c >> 32) : ts_hi; ++nts; } } while (0)
    PG8_STAMP();
    unsigned voffA[2], voffB[2];
#pragma unroll
    for (int i = 0; i < 2; ++i) { int R, C; stage_rc(tid * 16 + i * 8192, R, C); const int Rb = Epi::PERM ? ((R & ~31) + perm32(R & 31)) : R;
        voffA[i] = (unsigned)(R * K + C) * 2u; voffB[i] = (unsigned)(Rb * K + C) * 2u; }
    const size_t kstep = (size_t)(BK * 2);
    const size_t hstep = (size_t)HALF * K * 2;
    const size_t tstep = 2 * hstep;
    const unsigned ldsw = (unsigned)wid * 1024u;
    const int aoff = lds_byte(wr * 64 + fr, fq * 8), boff = lds_byte(wc * 32 + fr, fq * 8);
#define PG8_SA(b, h) (((b) * 2 + (h)) * HTB)
#define PG8_SB(b, h) ((4 + (b) * 2 + (h)) * HTB)
#define PG8_STAGE(bufoff, gbase, voff) do { _Pragma("unroll") for (int _i = 0; _i < 2; ++_i) \
        __builtin_amdgcn_global_load_lds((const unsigned*)((const char*)(gbase) + (voff)[_i]), (PG8_LAS unsigned*)(lds + (bufoff) + ldsw + _i * 8192), 16, 0, 0); } while (0)
#define PG8_LDA(dst, b, h) do { _Pragma("unroll") for (int m = 0; m < 4; ++m) _Pragma("unroll") for (int k = 0; k < 2; ++k) dst[m][k] = *(const PG8_LAS bf16x8*)(lds + PG8_SA(b, h) + aoff + m * 2048 + k * 1024); } while (0)
#define PG8_LDB(dst, b, h) do { _Pragma("unroll") for (int n = 0; n < 2; ++n) _Pragma("unroll") for (int k = 0; k < 2; ++k) dst[n][k] = *(const PG8_LAS bf16x8*)(lds + PG8_SB(b, h) + boff + n * 2048 + k * 1024); } while (0)
#define PG8_MMA(ai, bj, At, Bt) do { __builtin_amdgcn_s_setprio(1); _Pragma("unroll") for (int m = 0; m < 4; ++m) _Pragma("unroll") for (int n = 0; n < 2; ++n) _Pragma("unroll") for (int k = 0; k < 2; ++k) \
        acc[ai][bj][m][n] = __builtin_amdgcn_mfma_f32_16x16x32_bf16(Bt[n][k], At[m][k], acc[ai][bj][m][n], 0, 0, 0); __builtin_amdgcn_s_setprio(0); } while (0)
#define PG8_WAIT_V(n) asm volatile("s_waitcnt vmcnt(" #n ")" ::: "memory")
#define PG8_WAIT_L(n) asm volatile("s_waitcnt lgkmcnt(" #n ")" ::: "memory")
#define PG8_BAR __builtin_amdgcn_s_barrier()
#define PG8_SCHED __builtin_amdgcn_sched_barrier(0)
    Unit cur, nxt; int ui = 0;
    if (!S.next(0, cur)) return;
    f32x4 acc[2][2][4][2];
#pragma unroll
    for (int a = 0; a < 2; ++a)
#pragma unroll
        for (int b = 0; b < 2; ++b)
#pragma unroll
            for (int m = 0; m < 4; ++m)
#pragma unroll
                for (int n = 0; n < 2; ++n) acc[a][b][m][n] = (f32x4){0.f, 0.f, 0.f, 0.f};
    bf16x8 At[4][2], B0[2][2], B1[2][2];
    const char* cA = (const char*)g.A + (size_t)cur.pm * tstep; const char* cB = (const char*)g.Bt + (size_t)cur.pn * tstep;
    S.a_ready(cur);
    PG8_STAGE(PG8_SB(0, 0), cB, voffB); PG8_STAGE(PG8_SA(0, 0), cA, voffA); PG8_STAGE(PG8_SB(0, 1), cB + hstep, voffB); PG8_STAGE(PG8_SA(0, 1), cA + hstep, voffA);
    if (wr == 1) PG8_BAR;
    PG8_WAIT_V(4); PG8_BAR;
    PG8_STAGE(PG8_SB(1, 0), cB + kstep, voffB); PG8_STAGE(PG8_SA(1, 0), cA + kstep, voffA); PG8_STAGE(PG8_SB(1, 1), cB + hstep + kstep, voffB);
    PG8_WAIT_V(6); PG8_BAR;
    PG8_STAMP();
    for (;;) {
        const bool has_next = S.next(ui + 1, nxt);
        const char* nA = has_next ? (const char*)g.A + (size_t)nxt.pm * tstep : cA; const char* nB = has_next ? (const char*)g.Bt + (size_t)nxt.pn * tstep : cB;
        for (int t = 0; t < nt; t += 2) {
            const bool last = (t == nt - 2);
            const char* a1 = cA + (size_t)(t + 1) * kstep;
            const char* a2 = last ? nA : cA + (size_t)(t + 2) * kstep; const char* b2 = last ? nB : cB + (size_t)(t + 2) * kstep;
            const char* a3 = a2 + kstep; const char* b3 = b2 + kstep;
            if (last && has_next) S.a_ready(nxt);
            PG8_LDB(B0, 0, 0); PG8_SCHED; PG8_LDA(At, 0, 0); PG8_STAGE(PG8_SA(1, 1), a1 + hstep, voffA);
            PG8_WAIT_L(8); PG8_BAR; PG8_WAIT_L(0); PG8_MMA(0, 0, At, B0); PG8_BAR; PG8_SCHED;
            PG8_LDB(B1, 0, 1); PG8_STAGE(PG8_SB(0, 0), b2, voffB);
            PG8_BAR; PG8_WAIT_L(0); PG8_MMA(0, 1, At, B1); PG8_BAR;
            PG8_LDA(At, 0, 1); PG8_STAGE(PG8_SA(0, 0), a2, voffA);
            PG8_BAR; PG8_WAIT_L(0); PG8_MMA(1, 0, At, B0); PG8_BAR; PG8_SCHED;
            PG8_STAGE(PG8_SB(0, 1), b2 + hstep, voffB);
            PG8_WAIT_V(6); PG8_BAR; PG8_MMA(1, 1, At, B1); PG8_BAR;
            PG8_LDB(B0, 1, 0); PG8_SCHED; PG8_LDA(At, 1, 0); PG8_STAGE(PG8_SA(0, 1), a2 + hstep, voffA);
            PG8_WAIT_L(8); PG8_BAR; PG8_WAIT_L(0); PG8_MMA(0, 0, At, B0); PG8_BAR; PG8_SCHED;
            PG8_LDB(B1, 1, 1); PG8_STAGE(PG8_SB(1, 0), b3, voffB);
            PG8_BAR; PG8_WAIT_L(0); PG8_MMA(0, 1, At, B1); PG8_BAR;
            PG8_LDA(At, 1, 1); PG8_STAGE(PG8_SA(1, 0), a3, voffA);
            PG8_BAR; PG8_WAIT_L(0); PG8_MMA(1, 0, At, B0); PG8_BAR; PG8_SCHED;
            PG8_STAGE(PG8_SB(1, 1), b3 + hstep, voffB);
            PG8_WAIT_V(6); PG8_BAR; PG8_MMA(1, 1, At, B1); PG8_BAR;
        }
        PG8_STAMP();
        if constexpr (!Epi::AFTER_DRAIN) { E(acc, cur, wr, wc, fr, fq); S.done(cur); }
        PG8_STAMP();
        if (!has_next) break;
#pragma unroll
        for (int a = 0; a < 2; ++a)
#pragma unroll
            for (int b = 0; b < 2; ++b)
#pragma unroll
                for (int m = 0; m < 4; ++m)
#pragma unroll
                    for (int n = 0; n < 2; ++n) acc[a][b][m][n] = (f32x4){0.f, 0.f, 0.f, 0.f};
        cur = nxt; cA = nA; cB = nB; ++ui;
    }
    PG8_WAIT_V(0);
    if (wr == 0) PG8_BAR;
    PG8_BAR;
    if constexpr (Epi::AFTER_DRAIN) { E.fused(acc, cur, wr, wc, fr, fq, lds, wid, lane); S.done(cur); }
    PG8_STAMP();
    if (STAMP && wid == 0) { stamps[lane] = lane < nts ? (((unsigned long long)(unsigned)ts_hi << 32) | (unsigned)ts_lo) : 0ull;
        if (lane == 62) stamps[62] = rt_entry; if (lane == 63) stamps[63] = (unsigned long long)wall_clock64(); }
#undef PG8_STAMP
#undef PG8_SA
#undef PG8_SB
#undef PG8_STAGE
#undef PG8_LDA
#undef PG8_LDB
#undef PG8_MMA
#undef PG8_WAIT_V
#undef PG8_WAIT_L
#undef PG8_BAR
#undef PG8_SCHED
}
}


using pg8::bf16_t; using pg8::bf16x8; using pg8::f32x4; using pg8::u32x4;
typedef float f32x2v __attribute__((ext_vector_type(2)));
typedef unsigned u32x2 __attribute__((ext_vector_type(2)));
#define LAS __attribute__((address_space(3)))

#define XB_TMO      128
#define XB_XCNT(j)  (256  + 64 * (j))
#define XB_XSUB(j)  (1280 + 64 * (j))
#define XB_XGEN(j)  (2304 + 64 * (j))
#define XB_TOP      3328
#define XB_TOPGEN   3392
#define XCD_BAR_WORDS 3456
#define XB_SPIN_CAP (1u << 18)

__device__ __forceinline__ unsigned xb_ld(unsigned* p)              { return __hip_atomic_load(p, __ATOMIC_RELAXED, __HIP_MEMORY_SCOPE_AGENT); }
__device__ __forceinline__ unsigned xb_add(unsigned* p, unsigned v) { return __hip_atomic_fetch_add(p, v, __ATOMIC_RELAXED, __HIP_MEMORY_SCOPE_AGENT); }
__device__ __forceinline__ unsigned xb_xcc_id() { return (unsigned)__builtin_amdgcn_s_getreg((3 << 11) | 20) & 0xFu; }
#define XB_SPIN(cond, bar) do { unsigned _sp = 0; while (cond) { __builtin_amdgcn_s_sleep(1); \
    if ((++_sp & 255u) == 0u) { if (xb_ld(&(bar)[XB_TMO])) break; if (_sp > XB_SPIN_CAP) { atomicAdd(&(bar)[XB_TMO], 1u); break; } } } } while (0)

struct XcdBarrier {
    unsigned* bar; unsigned x;
    volatile LAS unsigned* st;
};

__device__ __forceinline__ XcdBarrier xcd_barrier_post(unsigned* bar, volatile LAS unsigned* st) {
    XcdBarrier b; b.bar = bar; b.x = xb_xcc_id(); b.st = st;
    if (threadIdx.x == 0) (void)xb_add(&bar[XB_XCNT(b.x)], 1u);
    return b;
}
__device__ __forceinline__ void xcd_barrier_complete(unsigned* bar, unsigned x, unsigned& nloc, unsigned& nx) {
    const unsigned G = gridDim.x * gridDim.y * gridDim.z;
    unsigned sum, cnt, mine, sp = 0u;
    for (;;) {
        sum = 0u; cnt = 0u; mine = 0u;
#pragma unroll
        for (unsigned j = 0; j < 16; ++j) { const unsigned c = xb_ld(&bar[XB_XCNT(j)]); sum += c; cnt += (c > 0u) ? 1u : 0u; mine = (j == x) ? c : mine; }
        if (sum == G) break;
        __builtin_amdgcn_s_sleep(1);
        if ((++sp & 255u) == 0u) { if (xb_ld(&bar[XB_TMO])) break; if (sp > XB_SPIN_CAP) { atomicAdd(&bar[XB_TMO], 1u); break; } }
    }
    nloc = mine > 0u ? mine : 1u; nx = cnt > 0u ? cnt : 1u;
}

__device__ __forceinline__ void xcd_barrier(const XcdBarrier& b) {
    asm volatile("s_waitcnt vmcnt(0)" ::: "memory");
    __syncthreads();
    if (threadIdx.x == 0) {
        unsigned* bar = b.bar;
        __builtin_amdgcn_s_waitcnt(0);
        unsigned nloc = b.st[0], nx = b.st[1];
        if (nloc == 0u) { xcd_barrier_complete(bar, b.x, nloc, nx); b.st[0] = nloc; b.st[1] = nx; }
        const unsigned old = xb_add(&bar[XB_XSUB(b.x)], 1u);
        const unsigned gen = old / nloc;
        if (old + 1u == (gen + 1u) * nloc) {
            __builtin_amdgcn_fence(__ATOMIC_RELEASE, "agent");
            asm volatile("s_waitcnt vmcnt(0)" ::: "memory");
            const unsigned og = xb_add(&bar[XB_TOP], 1u);
            const unsigned tg = og / nx;
            if (og + 1u == (tg + 1u) * nx) xb_add(&bar[XB_TOPGEN], 1u);
            else XB_SPIN(xb_ld(&bar[XB_TOPGEN]) == tg, bar);
            __builtin_amdgcn_fence(__ATOMIC_ACQUIRE, "agent");
            xb_add(&bar[XB_XGEN(b.x)], 1u);
            asm volatile("s_waitcnt vmcnt(0)" ::: "memory");
        } else {
            XB_SPIN(xb_ld(&bar[XB_XGEN(b.x)]) == gen, bar);
            __builtin_amdgcn_fence(__ATOMIC_ACQUIRE, "agent");
            asm volatile("s_waitcnt vmcnt(0)" ::: "memory");
        }
    }
    __syncthreads();
}

constexpr int T = 65536, DM = 1024, SEQ = 2048;
constexpr float EPS = 1e-6f;
constexpr float SU = 64.f, SV = 5.5f;
constexpr float XS = 2.f;
constexpr int LDS_BYTES = 160 * 1024;

constexpr size_t al256(size_t x) { return (x + 255) / 256 * 256; }
constexpr size_t WS_BT1 = 0;
constexpr size_t WS_BT2 = WS_BT1 + al256((size_t)3072 * 1024 * 2);
constexpr size_t WS_BT3 = WS_BT2 + al256((size_t)1024 * 1024 * 2);
constexpr size_t WS_BT5 = WS_BT3 + al256((size_t)2 * 2048 * 1024 * 2);
constexpr size_t WS_BT6 = WS_BT5 + al256((size_t)768 * 1024 * 2);
constexpr size_t WS_BT7 = WS_BT6 + al256((size_t)1536 * 384 * 2);
constexpr size_t WS_BT9 = WS_BT7 + al256((size_t)2048 * 256 * 2);
constexpr size_t WS_ROPE = WS_BT9 + al256((size_t)1024 * 1024 * 2);
constexpr size_t WS_UT8 = WS_ROPE + al256((size_t)2 * 2048 * 16 * 4);
constexpr size_t WS_VT8 = WS_UT8 + al256((size_t)2 * 16384 * 1024);
constexpr size_t WS_SSQ = WS_VT8 + al256((size_t)2 * 16384 * 1024);
constexpr size_t WS_SSQ2 = WS_SSQ + al256((size_t)T * 16 * 4);
constexpr size_t WS_ASC = WS_SSQ2 + al256((size_t)T * 8 * 4);
constexpr size_t WS_XB = WS_ASC + al256((size_t)T * 4);
constexpr size_t WS_BIG = WS_XB + al256((size_t)T * 1024 * 2);
constexpr size_t BIG_BYTES = (size_t)T * 2048 * 4;
constexpr size_t WS_MISC = WS_BIG + BIG_BYTES;
constexpr size_t MS_IDX = 0;
constexpr size_t MS_GATE = MS_IDX + (size_t)T * 128 * 4;
constexpr size_t MS_X3B = MS_GATE + (size_t)T * 128 * 4;
constexpr size_t MS_CQ = MS_X3B;
constexpr size_t MS_CKV = MS_CQ + (size_t)T * 384 * 2;
constexpr size_t MS_KR = MS_CKV + (size_t)T * 256 * 2;
static_assert(MS_KR + (size_t)T * 32 * 2 <= MS_X3B + (size_t)T * 1024 * 2, "cq/ckv/kr inside the x3b slot");
constexpr size_t MISC_BYTES = MS_X3B + (size_t)T * 1024 * 2;
constexpr size_t WS_BAR = WS_MISC + MISC_BYTES;
constexpr size_t WS_END = WS_BAR + al256((size_t)XCD_BAR_WORDS * 4) + 8192;
constexpr size_t BG_XQ = (size_t)384 * 1024 * 1024;
constexpr size_t BG_SLOTS = (size_t)352 * 1024 * 1024;
constexpr size_t BG_SCORES = (size_t)64 * 1024 * 1024;
constexpr size_t BG_UB = 0, BG_BB = (size_t)T * 1024 * 2;
constexpr size_t BG_LATQ = 0, BG_KV = (size_t)T * 768 * 4;
static_assert(BG_KV + (size_t)T * 2048 * 2 <= BIG_BYTES, "mla buffers fit");

struct Params { const float* in[18]; float* out; unsigned char* ws; int ph_lo, ph_hi; };

__device__ __forceinline__ float row16_sum(float v) {
  v += __int_as_float(__builtin_amdgcn_update_dpp(0, __float_as_int(v), 0x128, 0xf, 0xf, false));
  v += __int_as_float(__builtin_amdgcn_update_dpp(0, __float_as_int(v), 0x124, 0xf, 0xf, false));
  v += __int_as_float(__builtin_amdgcn_update_dpp(0, __float_as_int(v), 0x122, 0xf, 0xf, false));
  v += __int_as_float(__builtin_amdgcn_update_dpp(0, __float_as_int(v), 0x121, 0xf, 0xf, false));
  return v;
}
__device__ __forceinline__ float wave_sum(float v) {
  v = row16_sum(v);
  v += __shfl_xor(v, 16, 64); v += __shfl_xor(v, 32, 64);
  return v;
}
__device__ __forceinline__ unsigned pkbf(float lo, float hi) { return pg8::cvt_pk_bf16(lo, hi); }
__device__ __forceinline__ float bflo(unsigned w) { return __uint_as_float(w << 16); }
__device__ __forceinline__ float bfhi(unsigned w) { return __uint_as_float(w & 0xffff0000u); }

template <class F>
__device__ __forceinline__ void tr_convert(const float* __restrict__ src, int N, int K, bf16_t* __restrict__ dst, int Np, F colmap, int gtid, int nthr, const float* __restrict__ kscale = nullptr) {
  const int items = Np * (K / 8);
  for (int idx = gtid; idx < items; idx += nthr) {
    const int kc = idx / Np, n = idx - kc * Np;
    const int c = colmap(n);
    float v[8];
#pragma unroll
    for (int i = 0; i < 8; i++) v[i] = (c >= 0) ? src[(size_t)(kc * 8 + i) * N + c] * (kscale ? kscale[kc * 8 + i] : 1.f) : 0.f;
    u32x4 w; w.x = pkbf(v[0], v[1]); w.y = pkbf(v[2], v[3]); w.z = pkbf(v[4], v[5]); w.w = pkbf(v[6], v[7]);
    *(u32x4*)(dst + (size_t)n * K + kc * 8) = w;
  }
}

__device__ __forceinline__ void prep_phase(const Params& p, LAS unsigned char* lds) {
  const int tid = opaque_tid(), lane = tid & 63, wid = tid >> 6;
  const int G = gridDim.x, gtid = blockIdx.x * 512 + tid, nthr = G * 512;
  const int gw = blockIdx.x * 8 + wid, nw = G * 8;
  unsigned char* ws = p.ws;
  for (int step_ = 0; step_ < 5; ++step_) {
  switch ((blockIdx.x & 1) ? (step_ + 3) % 5 : step_) {
  case 0: {
  {
    const float* x = p.in[0]; const float* g = p.in[1];
    bf16_t* xb = (bf16_t*)(ws + WS_XB); float* rinv = (float*)(ws + WS_ASC);
    (void)g;
    for (int t0 = gw; t0 < T; t0 += 2 * nw) {
      f32x4 v[2][4];
#pragma unroll
      for (int k = 0; k < 2; k++) { const int t = (t0 + k * nw < T) ? (t0 + k * nw) : t0;
#pragma unroll
        for (int i = 0; i < 4; i++) v[k][i] = *(const f32x4*)(x + (size_t)t * DM + lane * 16 + i * 4); }
#pragma unroll
      for (int k = 0; k < 2; k++) {
        const int t = t0 + k * nw;
        float ss = 0.f;
#pragma unroll
        for (int i = 0; i < 4; i++) ss += v[k][i].x * v[k][i].x + v[k][i].y * v[k][i].y + v[k][i].z * v[k][i].z + v[k][i].w * v[k][i].w;
        ss = wave_sum(ss);
        const float r = rsqrtf(ss * (1.f / DM) + EPS);
        u32x4 w0, w1;
        w0.x = pkbf(v[k][0].x * r, v[k][0].y * r); w0.y = pkbf(v[k][0].z * r, v[k][0].w * r);
        w0.z = pkbf(v[k][1].x * r, v[k][1].y * r); w0.w = pkbf(v[k][1].z * r, v[k][1].w * r);
        w1.x = pkbf(v[k][2].x * r, v[k][2].y * r); w1.y = pkbf(v[k][2].z * r, v[k][2].w * r);
        w1.z = pkbf(v[k][3].x * r, v[k][3].y * r); w1.w = pkbf(v[k][3].z * r, v[k][3].w * r);
        if (t < T) { *(u32x4*)(xb + (size_t)t * DM + lane * 16) = w0; *(u32x4*)(xb + (size_t)t * DM + lane * 16 + 8) = w1; if (lane == 0) rinv[t] = sqrtf(ss * (1.f / DM) + EPS); }
      }
    }
  }
  } break;
  case 1: {
  tr_convert(p.in[3], 3072, 1024, (bf16_t*)(ws + WS_BT1), 3072, [](int n) {
    if (n < 1024) return n;
    const int q = n - 1024, tile = q >> 8, r = q & 255;
    return (r < 128) ? (1024 + tile * 128 + r) : (2048 + tile * 128 + (r - 128)); }, gtid, nthr, p.in[1]);
  tr_convert(p.in[5], 1024, 1024, (bf16_t*)(ws + WS_BT2), 1024, [](int n) { return n; }, gtid, nthr);
  tr_convert(p.in[6], 672, 1024, (bf16_t*)(ws + WS_BT5), 768, [](int n) { return n < 672 ? n : -1; }, gtid, nthr, p.in[1] + DM);
  tr_convert(p.in[9], 1536, 384, (bf16_t*)(ws + WS_BT6), 1536, [](int n) { return n; }, gtid, nthr);
  tr_convert(p.in[10], 2048, 256, (bf16_t*)(ws + WS_BT7), 2048, [](int n) { return n; }, gtid, nthr);
  tr_convert(p.in[11], 1024, 1024, (bf16_t*)(ws + WS_BT9), 1024, [](int n) { return n; }, gtid, nthr);
  } break;
  case 2: {
  {
    LAS float* Wq_s = (LAS float*)lds;
    LAS float* Kh_s = (LAS float*)(lds + 64 * 128 * 4);
    for (int it = blockIdx.x; it < 512; it += G) {
      const int l = it >> 8, hh = (it >> 4) & 15, kr = it & 15, k0 = kr * 64;
      const float* Wq = p.in[12] + (size_t)l * 1024 * 2048;
      const float* Kh = ((hh & 1) ? p.in[14] : p.in[13]) + ((size_t)(l * 8 + (hh >> 1)) * 128) * 128;
      const float* gf = p.in[2] + l * DM;
      __syncthreads();
#pragma unroll
      for (int i = 0; i < 16; i++) { const int idx = tid + i * 512, r = idx >> 7, c = idx & 127; Wq_s[idx] = Wq[(size_t)(k0 + r) * 2048 + hh * 128 + c]; }
#pragma unroll
      for (int i = 0; i < 32; i++) { const int idx = tid + i * 512, n = idx >> 7, d = idx & 127; Kh_s[n * 129 + d] = Kh[idx]; }
      __syncthreads();
      const int n = tid & 127, kq = tid >> 7;
      float acc[16];
#pragma unroll
      for (int i = 0; i < 16; i++) acc[i] = 0.f;
      for (int d = 0; d < 128; d++) {
        const float kv = Kh_s[n * 129 + d];
#pragma unroll
        for (int i = 0; i < 16; i++) acc[i] += Wq_s[(kq * 16 + i) * 128 + d] * kv;
      }
      bf16_t* dst = (bf16_t*)(ws + WS_BT3) + ((size_t)l * 2048 + hh * 128 + n) * 1024 + k0 + kq * 16;
      const float* gk = gf + k0 + kq * 16;
      u32x4 w0, w1;
      w0.x = pkbf(acc[0] * gk[0], acc[1] * gk[1]); w0.y = pkbf(acc[2] * gk[2], acc[3] * gk[3]);
      w0.z = pkbf(acc[4] * gk[4], acc[5] * gk[5]); w0.w = pkbf(acc[6] * gk[6], acc[7] * gk[7]);
      w1.x = pkbf(acc[8] * gk[8], acc[9] * gk[9]); w1.y = pkbf(acc[10] * gk[10], acc[11] * gk[11]);
      w1.z = pkbf(acc[12] * gk[12], acc[13] * gk[13]); w1.w = pkbf(acc[14] * gk[14], acc[15] * gk[15]);
      *(u32x4*)dst = w0; *(u32x4*)(dst + 8) = w1;
    }
    __syncthreads();
  }
  } break;
  case 3: {
  {
    const int items = 4 * 16384 * 64;
    for (int idx0 = gtid; idx0 < items; idx0 += 2 * nthr) {
      f32x4 v[2][4], g4[2][4];
#pragma unroll
      for (int k = 0; k < 2; k++) {
        const int idx = (idx0 + k * nthr < items) ? (idx0 + k * nthr) : idx0;
        const int part = idx & 63, e = (idx >> 6) & 16383, tb = (idx >> 20) & 1, l = idx >> 21;
        const float* src = (tb ? p.in[16] : p.in[15]) + ((size_t)l * 16384 + e) * DM + part * 16;
        const float* gf = p.in[2] + l * DM + part * 16;
#pragma unroll
        for (int i = 0; i < 4; i++) { v[k][i] = *(const f32x4*)(src + i * 4); g4[k][i] = *(const f32x4*)(gf + i * 4); }
      }
#pragma unroll
      for (int k = 0; k < 2; k++) {
        const int idx = idx0 + k * nthr;
        if (idx < items) {
          const int part = idx & 63, e = (idx >> 6) & 16383, tb = (idx >> 20) & 1, l = idx >> 21;
          unsigned w[4];
#pragma unroll
          for (int i = 0; i < 4; i++) {
            f32x4 vv = v[k][i];
            if (tb == 0) vv = vv * g4[k][i] * SU; else vv = vv * SV;
            unsigned q = __builtin_amdgcn_cvt_pk_fp8_f32(vv.x, vv.y, 0u, false);
            q = __builtin_amdgcn_cvt_pk_fp8_f32(vv.z, vv.w, q, true);
            w[i] = q;
          }
          if (tb == 0) {
            unsigned q4[2] = {0u, 0u};
#pragma unroll
            for (int i = 0; i < 4; i++) {
              const f32x4 vv = v[k][i] * g4[k][i] * SU;
#pragma unroll
              for (int j = 0; j < 4; j++) {
                const float a = fabsf(vv[j]);
                const unsigned code = (unsigned)(a > 0.25f) + (unsigned)(a > 0.75f) + (unsigned)(a > 1.25f) + (unsigned)(a > 1.75f) + (unsigned)(a > 2.5f) + (unsigned)(a > 3.5f) + (unsigned)(a > 5.0f);
                const unsigned nib = code | ((vv[j] < 0.f) ? 8u : 0u);
                q4[i >> 1] |= nib << (4 * ((i & 1) * 4 + j));
              }
            }
            *(u32x2*)(ws + WS_UT8 + ((size_t)l * 16384 + e) * 512 + part * 8) = (u32x2){q4[0], q4[1]};
          } else {
            unsigned char* row = ws + WS_VT8 + (((size_t)(l * 8 + (part >> 3)) * 16384 + e) * 64);
            const int pp = part & 7;
            const f32x4 va0 = v[k][0] * SV, va1 = v[k][1] * SV, vb0 = v[k][2] * SV, vb1 = v[k][3] * SV;
            unsigned qa = 0u, qb = 0u;
            qa = __builtin_amdgcn_cvt_scalef32_pk_fp4_f32(qa, va0[0], va0[1], 1.0f, 0); qa = __builtin_amdgcn_cvt_scalef32_pk_fp4_f32(qa, va0[2], va0[3], 1.0f, 1);
            qa = __builtin_amdgcn_cvt_scalef32_pk_fp4_f32(qa, va1[0], va1[1], 1.0f, 2); qa = __builtin_amdgcn_cvt_scalef32_pk_fp4_f32(qa, va1[2], va1[3], 1.0f, 3);
            qb = __builtin_amdgcn_cvt_scalef32_pk_fp4_f32(qb, vb0[0], vb0[1], 1.0f, 0); qb = __builtin_amdgcn_cvt_scalef32_pk_fp4_f32(qb, vb0[2], vb0[3], 1.0f, 1);
            qb = __builtin_amdgcn_cvt_scalef32_pk_fp4_f32(qb, vb1[0], vb1[1], 1.0f, 2); qb = __builtin_amdgcn_cvt_scalef32_pk_fp4_f32(qb, vb1[2], vb1[3], 1.0f, 3);
#pragma unroll
            for (int nb = 0; nb < 4; nb++) *(unsigned short*)(row + 16 * nb + 2 * pp) = (unsigned short)(((qa >> (8 * nb)) & 0xffu) | (((qb >> (8 * nb)) & 0xffu) << 8));
          }
        }
      }
    }
  }
  } break;
  default: {
  {
    float* rc = (float*)(ws + WS_ROPE); float* rs = rc + 2048 * 16;
    for (int idx = gtid; idx < 2048 * 16; idx += nthr) {
      const int pos = idx >> 4, i = idx & 15;
      const float inv = powf(10000.0f, -(float)(2 * i) / 32.0f);
      const float ang = (float)pos * inv;
      rc[idx] = cosf(ang); rs[idx] = sinf(ang);
    }
  }
  } break;
  }
  }
}

struct EpiConv {
  static constexpr bool PERM = true, AFTER_DRAIN = false;
  bf16_t* bb; bf16_t* ub;
  __device__ __forceinline__ void operator()(const f32x4 (&acc)[2][2][4][2], const pg8::Unit& u, int wr, int wc, int fr, int fq) const {
    asm volatile("" : "+v"(fr), "+v"(fq));
    const int row0 = u.pm * 256 + wr * 64 + fr;
    if (u.pn < 4) {
      const int col0 = u.pn * 256 + wc * 32 + 8 * fq;
#pragma unroll
      for (int ai = 0; ai < 2; ++ai)
#pragma unroll
        for (int m = 0; m < 4; ++m) {
          bf16_t* rowp = bb + (size_t)(row0 + ai * 128 + m * 16) * DM + col0;
#pragma unroll
          for (int bj = 0; bj < 2; ++bj) {
            const f32x4 v0 = acc[ai][bj][m][0], v1 = acc[ai][bj][m][1];
            u32x4 w; w.x = pkbf(v0[0], v0[1]); w.y = pkbf(v0[2], v0[3]); w.z = pkbf(v1[0], v1[1]); w.w = pkbf(v1[2], v1[3]);
            *(u32x4*)(rowp + bj * 128) = w;
          }
        }
    } else {
      const int col0 = (u.pn - 4) * 128 + wc * 32 + 8 * fq;
#pragma unroll
      for (int ai = 0; ai < 2; ++ai)
#pragma unroll
        for (int m = 0; m < 4; ++m) {
          bf16_t* rowp = ub + (size_t)(row0 + ai * 128 + m * 16) * DM + col0;
          const f32x4 v0 = acc[ai][0][m][0] * acc[ai][1][m][0], v1 = acc[ai][0][m][1] * acc[ai][1][m][1];
          u32x4 w; w.x = pkbf(v0[0], v0[1]); w.y = pkbf(v0[2], v0[3]); w.z = pkbf(v1[0], v1[1]); w.w = pkbf(v1[2], v1[3]);
          *(u32x4*)rowp = w;
        }
    }
  }
};

template <bool BFRES  > struct EpiResid {
  static constexpr bool PERM = false, AFTER_DRAIN = false;
  const void* xin; bf16_t* xb; float* ssq; const float* rscale;
  __device__ __forceinline__ void operator()(const f32x4 (&acc)[2][2][4][2], const pg8::Unit& u, int wr, int wc, int fr, int fq) const {
    asm volatile("" : "+v"(fr), "+v"(fq));
    const int row0 = u.pm * 256 + wr * 64 + fr, col0 = u.pn * 256 + wc * 32 + 4 * fq;
#pragma unroll
    for (int ai = 0; ai < 2; ++ai) {
      f32x4 rbuf[4][2][2]; float rsc[4];
#pragma unroll
      for (int m = 0; m < 4; ++m) rsc[m] = (BFRES && rscale) ? rscale[row0 + ai * 128 + m * 16] : 1.f;
#pragma unroll
      for (int m = 0; m < 4; ++m)
#pragma unroll
        for (int bj = 0; bj < 2; ++bj)
#pragma unroll
          for (int n = 0; n < 2; ++n) {
            const size_t o = (size_t)(row0 + ai * 128 + m * 16) * DM + col0 + bj * 128 + n * 16;
            if (BFRES) { const u32x2 w = *(const u32x2*)((const bf16_t*)xin + o); rbuf[m][bj][n] = (f32x4){bflo(w.x), bfhi(w.x), bflo(w.y), bfhi(w.y)} * rsc[m]; }
            else rbuf[m][bj][n] = *(const f32x4*)((const float*)xin + o);
          }
      __builtin_amdgcn_sched_barrier(0);
#pragma unroll
      for (int m = 0; m < 4; ++m) {
        const int row = row0 + ai * 128 + m * 16;
        float s = 0.f;
#pragma unroll
        for (int bj = 0; bj < 2; ++bj)
#pragma unroll
          for (int n = 0; n < 2; ++n) {
            const size_t o = (size_t)row * DM + col0 + bj * 128 + n * 16;
            const f32x4 v = acc[ai][bj][m][n] + rbuf[m][bj][n];
            u32x2 w; w.x = pkbf(v[0], v[1]); w.y = pkbf(v[2], v[3]);
            *(u32x2*)(xb + o) = w;
            s += v[0] * v[0] + v[1] * v[1] + v[2] * v[2] + v[3] * v[3];
          }
        s += __shfl_xor(s, 16, 64); s += __shfl_xor(s, 32, 64);
        if (fq == 0) ssq[(size_t)row * 16 + u.pn * 4 + wc] = s;
      }
    }
  }
};

struct EpiQ {
  static constexpr bool PERM = false, AFTER_DRAIN = false;
  bf16_t* Q; const float* rc; const float* rs;
  __device__ __forceinline__ void operator()(const f32x4 (&acc)[2][2][4][2], const pg8::Unit& u, int wr, int wc, int fr, int fq) const {
    asm volatile("" : "+v"(fr), "+v"(fq));
    const int row0 = u.pm * 256 + wr * 64 + fr, col0 = u.pn * 256 + wc * 32 + 4 * fq;
#pragma unroll
    for (int ai = 0; ai < 2; ++ai) {
      f32x4 c4[4], s4[4];
#pragma unroll
      for (int m = 0; m < 4; ++m) { const int pos = (row0 + ai * 128 + m * 16) & (SEQ - 1);
        c4[m] = *(const f32x4*)(rc + pos * 16 + 4 * fq); s4[m] = *(const f32x4*)(rs + pos * 16 + 4 * fq); }
      __builtin_amdgcn_sched_barrier(0);
#pragma unroll
      for (int m = 0; m < 4; ++m) {
        const int row = row0 + ai * 128 + m * 16;
#pragma unroll
        for (int bj = 0; bj < 2; ++bj) {
          const int grp = u.pn * 8 + bj * 4 + wc;
          f32x4 v0 = acc[ai][bj][m][0], v1 = acc[ai][bj][m][1];
          if (grp % 3 == 2) { const f32x4 o0 = v0 * c4[m] - v1 * s4[m], o1 = v1 * c4[m] + v0 * s4[m]; v0 = o0; v1 = o1; }
          bf16_t* dst = Q + (size_t)row * 1536 + col0 + bj * 128;
          u32x2 w0, w1; w0.x = pkbf(v0[0], v0[1]); w0.y = pkbf(v0[2], v0[3]); w1.x = pkbf(v1[0], v1[1]); w1.y = pkbf(v1[2], v1[3]);
          *(u32x2*)dst = w0; *(u32x2*)(dst + 16) = w1;
        }
      }
    }
  }
};

__device__ __forceinline__ void convz_phase(const Params& p) {
  const int gtid = blockIdx.x * 512 + opaque_tid(), nthr = gridDim.x * 512;
  const bf16_t* ub = (const bf16_t*)(p.ws + WS_BIG + BG_UB);
  bf16_t* bb = (bf16_t*)(p.ws + WS_BIG + BG_BB);
  const float* cw = p.in[4];
  const int d8 = gtid & 127;
  float w0[8], w1[8], w2[8];
#pragma unroll
  for (int i = 0; i < 8; i++) { w0[i] = cw[d8 * 8 + i]; w1[i] = cw[DM + d8 * 8 + i]; w2[i] = cw[2 * DM + d8 * 8 + i]; }
  constexpr int UNR = 4;
  for (int idx0 = gtid; idx0 < T * 128; idx0 += nthr * UNR) {
    u32x4 uc[UNR], um[UNR], up[UNR], bv[UNR];
#pragma unroll
    for (int k = 0; k < UNR; k++) {
      const int idx = idx0 + k * nthr;
      const int t = idx >> 7, sq = t & (SEQ - 1);
      const size_t o = (size_t)t * DM + d8 * 8;
      um[k] = (u32x4){0u, 0u, 0u, 0u}; up[k] = (u32x4){0u, 0u, 0u, 0u}; uc[k] = um[k]; bv[k] = um[k];
      if (idx < T * 128) {
        uc[k] = *(const u32x4*)(ub + o);
        if (sq > 0) um[k] = *(const u32x4*)(ub + o - DM);
        if (sq < SEQ - 1) up[k] = *(const u32x4*)(ub + o + DM);
        bv[k] = *(const u32x4*)(bb + o);
      }
    }
#pragma unroll
    for (int k = 0; k < UNR; k++) {
      const int idx = idx0 + k * nthr;
      if (idx < T * 128) {
        const size_t o = (size_t)(idx >> 7) * DM + d8 * 8;
        unsigned ow[4];
#pragma unroll
        for (int i = 0; i < 4; i++) {
          const float ylo = w0[2 * i] * bflo(um[k][i]) + w1[2 * i] * bflo(uc[k][i]) + w2[2 * i] * bflo(up[k][i]);
          const float yhi = w0[2 * i + 1] * bfhi(um[k][i]) + w1[2 * i + 1] * bfhi(uc[k][i]) + w2[2 * i + 1] * bfhi(up[k][i]);
          ow[i] = pkbf(bflo(bv[k][i]) * ylo, bfhi(bv[k][i]) * yhi);
        }
        *(u32x4*)(bb + o) = (u32x4){ow[0], ow[1], ow[2], ow[3]};
      }
    }
  }
}

__device__ __forceinline__ int mono(float f) { const int b = __float_as_int(f); return b ^ ((b >> 31) & 0x7fffffff); }
__device__ __forceinline__ float unmono(int k) { return __int_as_float(k ^ ((k >> 31) & 0x7fffffff)); }
__device__ __forceinline__ int imax(int a, int b) { return a > b ? a : b; }
__device__ __forceinline__ int imin(int a, int b) { return a < b ? a : b; }

__device__ __forceinline__ void sort16_desc(int (&a)[16]) {
#pragma unroll
  for (int k = 2; k <= 16; k <<= 1) {
#pragma unroll
    for (int j = k >> 1; j > 0; j >>= 1) {
#pragma unroll
      for (int i = 0; i < 16; i++) {
        const int l = i ^ j;
        if (l > i) {
          const bool desc = ((i & k) == 0);
          const int hi = imax(a[i], a[l]), lo = imin(a[i], a[l]);
          a[i] = desc ? hi : lo; a[l] = desc ? lo : hi;
        }
      }
    }
  }
}
__device__ __forceinline__ void merge16_desc(int (&t)[16], const int (&g)[16]) {
#pragma unroll
  for (int i = 0; i < 16; i++) t[i] = imax(t[i], g[15 - i]);
#pragma unroll
  for (int j = 8; j > 0; j >>= 1) {
#pragma unroll
    for (int i = 0; i < 16; i++) {
      const int l = i ^ j;
      if (l > i) { const int hi = imax(t[i], t[l]), lo = imin(t[i], t[l]); t[i] = hi; t[l] = lo; }
    }
  }
}

constexpr int TK_ROW = 68;
constexpr int TK_LUT_OFF = 512 * TK_ROW * 4;
constexpr int TK_LUT_STRIDE = 36;

__device__ __forceinline__ void topk_phase(const Params& p, LAS unsigned char* lds, int l) {
  const int tid = opaque_tid();
  const bf16_t* scores = (const bf16_t*)(p.ws + WS_BIG + BG_SCORES);
  const float* ssq = (const float*)(p.ws + WS_SSQ);
  int* eidx = (int*)(p.ws + WS_MISC + MS_IDX);
  float* gate = (float*)(p.ws + WS_MISC + MS_GATE);
  LAS unsigned* sl = (LAS unsigned*)lds;
  LAS unsigned char* lut = lds + TK_LUT_OFF + tid * TK_LUT_STRIDE;
#define TK_LOAD(PF, TILE, HALF) do { _Pragma("unroll") for (int it_ = 0; it_ < 16; it_++) { const int q_ = it_ * 512 + tid, pair_ = q_ >> 4, piece_ = q_ & 15; \
    PF[it_] = *(const u32x4*)(scores + (size_t)((TILE) * 64 + (pair_ >> 3)) * 2048 + (pair_ & 7) * 256 + (HALF) * 128 + piece_ * 8); } } while (0)
  u32x4 pf[16];
  if ((int)blockIdx.x < T / 64) TK_LOAD(pf, (int)blockIdx.x, 0);
  for (int tile = blockIdx.x; tile < T / 64; tile += gridDim.x) {
    const int t0 = tile * 64;
    int T1[16], T2[16];
#pragma unroll
    for (int half = 0; half < 2; half++) {
      int TT[16];
      __syncthreads();
#pragma unroll
      for (int it = 0; it < 16; it++) { const int q = it * 512 + tid, pair = q >> 4, piece = q & 15; *(LAS u32x4*)(sl + pair * TK_ROW + piece * 4) = pf[it]; }
      __syncthreads();
      if (half == 0) TK_LOAD(pf, tile, 1);
#pragma unroll
      for (int g = 0; g < 8; g++) {
        int G[16];
#pragma unroll
        for (int q4 = 0; q4 < 2; q4++) {
          const u32x4 v = *(const LAS u32x4*)(sl + tid * TK_ROW + g * 8 + q4 * 4);
#pragma unroll
          for (int j = 0; j < 4; j++) {
            const int n = g * 16 + q4 * 8 + j * 2;
            G[q4 * 8 + j * 2] = (mono(bflo(v[j])) & ~127) | (127 - n);
            G[q4 * 8 + j * 2 + 1] = (mono(bfhi(v[j])) & ~127) | (127 - (n + 1));
          }
        }
        sort16_desc(G);
        if (g == 0) {
#pragma unroll
          for (int i = 0; i < 16; i++) TT[i] = G[i];
        } else merge16_desc(TT, G);
      }
#pragma unroll
      for (int i = 0; i < 16; i++) { if (half == 0) T1[i] = TT[i]; else T2[i] = TT[i]; }
    }
    float v1[16], v2[16];
    unsigned i1w[4] = {0u, 0u, 0u, 0u}, i2w[4] = {0u, 0u, 0u, 0u};
#pragma unroll
    for (int i = 0; i < 16; i++) {
      v1[i] = unmono(T1[i] & ~127); v2[i] = unmono(T2[i] & ~127);
      i1w[i >> 2] |= (unsigned)(127 - (T1[i] & 127)) << (8 * (i & 3));
      i2w[i >> 2] |= (unsigned)(127 - (T2[i] & 127)) << (8 * (i & 3));
    }
#pragma unroll
    for (int i = 0; i < 4; i++) { *(LAS unsigned*)(lut + i * 4) = i1w[i]; *(LAS unsigned*)(lut + 16 + i * 4) = i2w[i]; }
#define CAND(i, j) ((mono(v1[i] + v2[j]) & ~255) | (255 - ((i) * 16 + (j))))
    int R[16];
#pragma unroll
    for (int j = 0; j < 16; j++) R[j] = CAND(0, j);
    {
      int G1[16] = {CAND(1, 0), CAND(1, 1), CAND(1, 2), CAND(1, 3), CAND(1, 4), CAND(1, 5), CAND(1, 6), CAND(1, 7),
                    CAND(2, 0), CAND(2, 1), CAND(2, 2), CAND(2, 3), CAND(2, 4), CAND(3, 0), CAND(3, 1), CAND(3, 2)};
      sort16_desc(G1); merge16_desc(R, G1);
      int G2[16] = {CAND(3, 3), CAND(4, 0), CAND(4, 1), CAND(4, 2), CAND(5, 0), CAND(5, 1), CAND(6, 0), CAND(6, 1),
                    CAND(7, 0), CAND(7, 1), CAND(8, 0), CAND(9, 0), CAND(10, 0), CAND(11, 0), CAND(12, 0), CAND(13, 0)};
      sort16_desc(G2); merge16_desc(R, G2);
      int xa = CAND(14, 0), xb2 = CAND(15, 0);
#pragma unroll
      for (int r = 0; r < 16; r++) { const int hi = imax(R[r], xa), lo = imin(R[r], xa); R[r] = hi; xa = lo; }
#pragma unroll
      for (int r = 0; r < 16; r++) { const int hi = imax(R[r], xb2), lo = imin(R[r], xb2); R[r] = hi; xb2 = lo; }
    }
#undef CAND
    const int t = t0 + (tid >> 3), h = tid & 7;
    float sq = 0.f;
    {
      const f32x4 a0 = *(const f32x4*)(ssq + (size_t)t * 16), a1 = *(const f32x4*)(ssq + (size_t)t * 16 + 4);
      const f32x4 a2 = *(const f32x4*)(ssq + (size_t)t * 16 + 8), a3 = *(const f32x4*)(ssq + (size_t)t * 16 + 12);
      const f32x4 a = a0 + a1 + a2 + a3; sq = a[0] + a[1] + a[2] + a[3];
    }
    const float rstd = rsqrtf(sq * (1.f / DM) + EPS);
    float ev[16]; int ex[16]; float sum = 0.f;
    const float m0 = unmono(R[0] & ~255);
#pragma unroll
    for (int r = 0; r < 16; r++) {
      const float val = unmono(R[r] & ~255);
      ev[r] = __expf((val - m0) * rstd); sum += ev[r];
      const int pos = 255 - (R[r] & 255);
      const int a = lut[pos >> 4], b = lut[16 + (pos & 15)];
      ex[r] = a * 128 + b;
    }
    const float inv = 1.f / sum;
    __syncthreads();
    {
      LAS int* el = (LAS int*)lds;
      LAS float* gl = (LAS float*)(lds + 64 * 128 * 4);
#pragma unroll
      for (int q4 = 0; q4 < 4; q4++) {
        *(LAS u32x4*)(el + (tid >> 3) * 128 + (tid & 7) * 16 + q4 * 4) = (u32x4){(unsigned)ex[q4 * 4], (unsigned)ex[q4 * 4 + 1], (unsigned)ex[q4 * 4 + 2], (unsigned)ex[q4 * 4 + 3]};
        *(LAS f32x4*)(gl + (tid >> 3) * 128 + (tid & 7) * 16 + q4 * 4) = (f32x4){ev[q4 * 4] * inv, ev[q4 * 4 + 1] * inv, ev[q4 * 4 + 2] * inv, ev[q4 * 4 + 3] * inv};
      }
      __syncthreads();
      const int lane = tid & 63, wv = tid >> 6;
      unsigned short* slots = (unsigned short*)(p.ws + WS_BIG + BG_SLOTS);
      unsigned char* xq = p.ws + WS_BIG + BG_XQ; float* asc = (float*)(p.ws + WS_ASC);
      const bf16_t* xbf = l ? (const bf16_t*)(p.ws + WS_MISC + MS_X3B) : (const bf16_t*)(p.ws + WS_XB);
      u32x4 xw0[8], xw1[8]; float xsq[8];
#pragma unroll
      for (int k = 0; k < 8; k++) { const size_t tt = (size_t)(t0 + wv * 8 + k);
        xw0[k] = *(const u32x4*)(xbf + tt * DM + lane * 16); xw1[k] = *(const u32x4*)(xbf + tt * DM + lane * 16 + 8); xsq[k] = ssq[tt * 16 + (lane & 15)]; }
#pragma unroll
      for (int k = 0; k < 8; k++) {
        const int tl = wv * 8 + k;
        const int e_lo = el[tl * 128 + lane], e_hi = el[tl * 128 + 64 + lane];
        const int b_lo = e_lo >> 11, b_hi = e_hi >> 11;
        int klo = 0, khi = 0, povl = 0, povh = 0, pov = 0;
        int base[8], pfr[8];
        int pf = 0;
#pragma unroll
        for (int b = 0; b < 8; b++) {
          const bool il = (b_lo == b), ih = (b_hi == b);
          const unsigned long long mlo = __ballot(il), mhi = __ballot(ih);
          const int clo = __popcll(mlo), cbb = clo + __popcll(mhi);
          const int rl = __builtin_amdgcn_mbcnt_hi((unsigned)(mlo >> 32), __builtin_amdgcn_mbcnt_lo((unsigned)mlo, 0u));
          const int rh = clo + __builtin_amdgcn_mbcnt_hi((unsigned)(mhi >> 32), __builtin_amdgcn_mbcnt_lo((unsigned)mhi, 0u));
          klo = il ? rl : klo; khi = ih ? rh : khi; povl = il ? pov : povl; povh = ih ? pov : povh;
          pfr[b] = pf; base[b] = 16 * b + cbb - pf;
          pov += (cbb > 16 ? cbb - 16 : 0); pf += (cbb < 16 ? 16 - cbb : 0);
        }
        const int o_lo = povl + klo - 16, o_hi = povh + khi - 16;
        int al = base[0], ah = base[0];
#pragma unroll
        for (int b = 1; b < 8; b++) { al = (o_lo >= pfr[b]) ? base[b] : al; ah = (o_hi >= pfr[b]) ? base[b] : ah; }
        const int r_lo = (klo < 16) ? 16 * b_lo + klo : o_lo + al;
        const int r_hi = (khi < 16) ? 16 * b_hi + khi : o_hi + ah;
        unsigned short* sp = slots + (size_t)(t0 + tl) * 128;
        sp[r_lo] = (unsigned short)e_lo;
        sp[r_hi] = (unsigned short)e_hi;
        float* gsp = gate + (size_t)(t0 + tl) * 128;
        gsp[r_lo] = gl[tl * 128 + lane];
        gsp[r_hi] = gl[tl * 128 + 64 + lane];
        {
          const size_t tt = (size_t)(t0 + tl);
          const u32x4 w0 = xw0[k], w1 = xw1[k];
          float sq = xsq[k];
          sq = row16_sum(sq);
          const float rs = rsqrtf(sq * (1.f / DM) + EPS) * XS;
          unsigned q0 = 0u, q1 = 0u;
#define TK_F4(Q, W, SEL0) do { const unsigned wa_ = (W)[0], wb_ = (W)[1]; (void)wa_; (void)wb_; } while (0)
          {
            const float f0 = bflo(w0[0]) * rs, f1 = bfhi(w0[0]) * rs, f2 = bflo(w0[1]) * rs, f3 = bfhi(w0[1]) * rs, f4 = bflo(w0[2]) * rs, f5 = bfhi(w0[2]) * rs, f6 = bflo(w0[3]) * rs, f7 = bfhi(w0[3]) * rs;
            q0 = __builtin_amdgcn_cvt_scalef32_pk_fp4_f32(q0, f0, f1, 1.0f, 0); q0 = __builtin_amdgcn_cvt_scalef32_pk_fp4_f32(q0, f2, f3, 1.0f, 1);
            q0 = __builtin_amdgcn_cvt_scalef32_pk_fp4_f32(q0, f4, f5, 1.0f, 2); q0 = __builtin_amdgcn_cvt_scalef32_pk_fp4_f32(q0, f6, f7, 1.0f, 3);
          }
          {
            const float f0 = bflo(w1[0]) * rs, f1 = bfhi(w1[0]) * rs, f2 = bflo(w1[1]) * rs, f3 = bfhi(w1[1]) * rs, f4 = bflo(w1[2]) * rs, f5 = bfhi(w1[2]) * rs, f6 = bflo(w1[3]) * rs, f7 = bfhi(w1[3]) * rs;
            q1 = __builtin_amdgcn_cvt_scalef32_pk_fp4_f32(q1, f0, f1, 1.0f, 0); q1 = __builtin_amdgcn_cvt_scalef32_pk_fp4_f32(q1, f2, f3, 1.0f, 1);
            q1 = __builtin_amdgcn_cvt_scalef32_pk_fp4_f32(q1, f4, f5, 1.0f, 2); q1 = __builtin_amdgcn_cvt_scalef32_pk_fp4_f32(q1, f6, f7, 1.0f, 3);
          }
#undef TK_F4
          *(u32x2*)(xq + tt * 512 + lane * 8) = (u32x2){q0, q1};
        }
      }
    }
    { const int nt = tile + (int)gridDim.x; if (nt < T / 64) TK_LOAD(pf, nt, 0); }
  }
#undef TK_LOAD
}

#define XSEL(c, a, b) ((c) ? (a) : (b))
__device__ __forceinline__ f32x2v dotacc_fp8(f32x2v s, const u32x4 q, const f32x2v (&x)[8]) {
#pragma unroll
  for (int w = 0; w < 4; w++) {
    const f32x2v lo = __builtin_amdgcn_cvt_pk_f32_fp8(q[w], false), hi = __builtin_amdgcn_cvt_pk_f32_fp8(q[w], true);
    s += lo * x[2 * w]; s += hi * x[2 * w + 1];
  }
  return s;
}
__device__ __forceinline__ float gelu_erf(float v) {
  const float av = fabsf(v), d = fmaf(av, 0.2316418882f, 1.0f), tt = __builtin_amdgcn_rcpf(d);
  float q = fmaf(tt, 0.5307027145f, -0.7265760135f); q = fmaf(q, tt, 0.7107068705f); q = fmaf(q, tt, -0.142248368f); q = fmaf(q, tt, 0.127414796f); q = q * tt;
  const float e = __builtin_amdgcn_exp2f(v * v * -0.72134752044f);
  const float m = v * (q * e);
  return v < 0.f ? m : v - m;
}

constexpr int UW_BYTES = 0;
typedef int i32x8 __attribute__((ext_vector_type(8)));
#define U_DPP(V, CTRL) __int_as_float(__builtin_amdgcn_update_dpp(0, __float_as_int(V), (CTRL), 0xf, 0xf, false))
__device__ __forceinline__ void peer_u_phase(const Params& p, int l, LAS unsigned char* lds, const int UVAR) {
  const int tid = opaque_tid(), lane = tid & 63, wid = tid >> 6;
  const int c = blockIdx.x, s = c & 7, rank = c >> 3, nrank = (gridDim.x + 7 - s) >> 3;
  const unsigned char* ut = p.ws + WS_UT8 + (size_t)l * 16384 * 512;
  const unsigned lpart = (unsigned)((lane >> 4) * 128 + (lane & 7) * 16);
  const unsigned short* slots = (const unsigned short*)(p.ws + WS_BIG + BG_SLOTS) + 16 * s + 8 * ((lane >> 3) & 1);
  const unsigned char* xq = p.ws + WS_BIG + BG_XQ + (lane >> 4) * 128 + (lane & 7) * 16; const float* asc = (const float*)(p.ws + WS_ASC);
  const bool b2 = (lane >> 2) & 1, c0 = ((lane ^ (lane >> 2)) & 1) != 0, c1 = (((lane >> 1) ^ (lane >> 2)) & 1) != 0;
  const bool sel1 = lane & 1, sel2 = (lane >> 1) & 1, valid = (lane >> 4) == ((lane >> 2) & 1);
  const int rho = 8 * ((lane >> 3) & 1) + (c0 ? 1 : 0) + (c1 ? 2 : 0) + (b2 ? 4 : 0);
  const float* gate = (const float*)(p.ws + WS_MISC + MS_GATE) + 16 * s + rho;
  bf16_t* abuf = ((UVAR == 0) ? (bf16_t*)(p.ws + WS_BIG) : (bf16_t*)(p.ws + WS_BIG + (size_t)400 * 1024 * 1024)) + 16 * s + rho;
  int stride = nrank * 8; asm volatile("" : "+s"(stride));
  const int t0 = rank * 8 + wid;
  if (t0 >= T) return;
  const int nit = (T - t0 + stride - 1) / stride;
#define U_TOK(I) (t0 + ((I) < nit ? (I) : nit - 1) * stride)
#define U_L64(V) ((long)(((unsigned long long)(V)[1] << 32) | (V)[0]))
#define U_H64(V) ((long)(((unsigned long long)(V)[3] << 32) | (V)[2]))
#ifdef REPEAT_U
  const unsigned umsk = (UVAR == 3) ? 2047u : 0xffffu, uorv = (UVAR == 3) ? ((unsigned)s << 11) : 0u;
#define U_OFFS(OF, IA) do { _Pragma("unroll") for (int r_ = 0; r_ < 4; r_++) { OF[2 * r_] = (((IA[r_] & umsk) | uorv) << 9) + lpart; OF[2 * r_ + 1] = ((((IA[r_] >> 16) & umsk) | uorv) << 9) + lpart; } } while (0)
#else
#define U_OFFS(OF, IA) do { _Pragma("unroll") for (int r_ = 0; r_ < 4; r_++) { OF[2 * r_] = ((IA[r_] & 0xffffu) << 9) + lpart; OF[2 * r_ + 1] = ((IA[r_] >> 16) << 9) + lpart; } } while (0)
#endif
  u32x4 tb[16], ida, idc, xr[4];
  float gvc, asc_c;
  {
    const size_t ta = (size_t)U_TOK(0), tb1 = (size_t)U_TOK(1), tc = (size_t)U_TOK(2), td = (size_t)U_TOK(3);
    const u32x4 i0a = *(const u32x4*)(slots + ta * 128);
    const u32x4 i1a = *(const u32x4*)(slots + tb1 * 128);
    __builtin_amdgcn_sched_barrier(0);
    ida = *(const u32x4*)(slots + tc * 128);
    idc = *(const u32x4*)(slots + td * 128);
    gvc = gate[ta * 128]; asc_c = 1.f / (SU * XS); (void)asc;
    xr[0] = *(const u32x4*)(xq + ta * 512);
    xr[1] = *(const u32x4*)(xq + tb1 * 512);
    __builtin_amdgcn_sched_barrier(0);
#pragma unroll
    for (int h = 0; h < 2; h++) {
      unsigned of[8]; if (h == 0) U_OFFS(of, i0a); else U_OFFS(of, i1a);
#pragma unroll
      for (int rp = 0; rp < 8; rp += 2) {
        tb[8 * h + rp] = *(const u32x4*)(ut + of[rp]); tb[8 * h + rp + 1] = *(const u32x4*)(ut + of[rp + 1]);
        __builtin_amdgcn_sched_barrier(0);
      }
    }
  }
  for (int ii = 0; ii < nit; ii += 4) {
#pragma unroll
    for (int h4 = 0; h4 < 4; h4++) {
      const int i = ii + h4, h = h4 & 1;
      const int t = U_TOK(i); const size_t tn1 = (size_t)U_TOK(i + 1), tn2 = (size_t)U_TOK(i + 2), tn4 = (size_t)U_TOK(i + 4);
      unsigned of[8]; U_OFFS(of, ida);
      ida = idc;
      idc = *(const u32x4*)(slots + tn4 * 128);
      const float gvn = gate[tn1 * 128], asn = asc_c;
      xr[(h4 + 2) & 3] = *(const u32x4*)(xq + tn2 * 512);
      __builtin_amdgcn_sched_barrier(0);
      const i32x8 xa = {(int)xr[h4][0], (int)xr[h4][1], (int)xr[h4][2], (int)xr[h4][3], 0, 0, 0, 0};
      float v[8];
#pragma unroll
      for (int rp = 0; rp < 8; rp += 2) {
        const f32x4 z = {0.f, 0.f, 0.f, 0.f};
        const int k0 = 8 * h + rp;
        const i32x8 b0 = {(int)tb[k0][0], (int)tb[k0][1], (int)tb[k0][2], (int)tb[k0][3], 0, 0, 0, 0};
        const i32x8 b1 = {(int)tb[k0 + 1][0], (int)tb[k0 + 1][1], (int)tb[k0 + 1][2], (int)tb[k0 + 1][3], 0, 0, 0, 0};
        const f32x4 a0 = __builtin_amdgcn_mfma_scale_f32_16x16x128_f8f6f4(xa, b0, z, 4  , 4  , 0, 0x7f7f7f7f, 0, 0x7f7f7f7f);
        const f32x4 a1 = __builtin_amdgcn_mfma_scale_f32_16x16x128_f8f6f4(xa, b1, z, 4, 4, 0, 0x7f7f7f7f, 0, 0x7f7f7f7f);
        __builtin_amdgcn_sched_barrier(0);
        tb[k0] = *(const u32x4*)(ut + of[rp]); tb[k0 + 1] = *(const u32x4*)(ut + of[rp + 1]);
        __builtin_amdgcn_sched_barrier(0);
        v[rp] = sel2 ? (sel1 ? a0[3] : a0[2]) : (sel1 ? a0[1] : a0[0]);
        v[rp + 1] = sel2 ? (sel1 ? a1[3] : a1[2]) : (sel1 ? a1[1] : a1[0]);
        __builtin_amdgcn_sched_barrier(0);
      }
      {
        float u[4];
#pragma unroll
        for (int k = 0; k < 4; k++) { const float keep = c0 ? v[2 * k + 1] : v[2 * k], send = c0 ? v[2 * k] : v[2 * k + 1]; const float sm = keep + U_DPP(send, 0xB1); u[k] = valid ? sm : 0.f; }
        float w[2];
#pragma unroll
        for (int k = 0; k < 2; k++) { const float keep = c1 ? u[2 * k + 1] : u[2 * k], send = c1 ? u[2 * k] : u[2 * k + 1]; w[k] = keep + U_DPP(send, 0x4E); }
        float zz = (b2 ? w[1] : w[0]) + U_DPP(b2 ? w[0] : w[1], 0x141);
        zz += __int_as_float(__builtin_amdgcn_ds_swizzle(__float_as_int(zz), 0x401F));
        const float hv = gelu_erf(zz * asc_c) * gvc;
        if (lane < 16 && i < nit) abuf[(size_t)t * 128] = (bf16_t)(pkbf(hv, 0.f) & 0xffffu);
      }
      __builtin_amdgcn_sched_barrier(0);
      gvc = gvn; asc_c = asn;
    }
  }
#undef U_TOK
#undef U_L64
#undef U_H64
#undef U_OFFS
}

constexpr float SH = 64.f;
constexpr int VM_BYTES = 768;
constexpr int VW_BYTES = 8 * 1024 + 2 * VM_BYTES + 2 * 256 + 64;
static_assert(8 * VW_BYTES <= LDS_BYTES - 64, "V phase LDS");
__device__ __forceinline__ long tr8_read(int addr) { long r; asm volatile("ds_read_b64_tr_b8 %0, %1" : "=&v"(r) : "v"(addr) : "memory"); return r; }
__device__ __forceinline__ long lds_read64(int addr) { long r; asm volatile("ds_read_b64 %0, %1" : "=&v"(r) : "v"(addr) : "memory"); return r; }
__device__ __forceinline__ void peer_v_phase(const Params& p, int l, LAS unsigned char* lds, int dry = 0) {
  const int tid = opaque_tid(), lane = tid & 63, wid = tid >> 6;
  const int c = blockIdx.x, s = c & 7, rank = c >> 3, nrank = (gridDim.x + 7 - s) >> 3;
  const unsigned char* vts = p.ws + WS_VT8 + ((size_t)(l * 8 + s) * 16384) * 64;
  const unsigned* slt = (const unsigned*)(p.ws + WS_BIG + BG_SLOTS);
  const unsigned* hbuf = (const unsigned*)(p.ws + WS_BIG);
  float* ssq2 = dry ? (float*)(p.ws + WS_BIG + (size_t)420 * 1024 * 1024) : (float*)(p.ws + WS_SSQ2);
  const bf16_t* xin = l ? (const bf16_t*)(p.ws + WS_MISC + MS_X3B) : (const bf16_t*)(p.ws + WS_XB);
  bf16_t* xb = dry ? (bf16_t*)(p.ws + WS_BIG + (size_t)330 * 1024 * 1024) : (l ? (bf16_t*)(p.ws + WS_MISC + MS_X3B) : (bf16_t*)(p.ws + WS_XB));
  LAS unsigned char* img = lds + wid * VW_BYTES;
  LAS unsigned char* mb = img + 8 * 1024;
  LAS unsigned char* hqb = mb + 2 * VM_BYTES;
  LAS unsigned char* zb = hqb + 512;
  if (lane < 16) *(LAS unsigned*)(zb + lane * 4) = 0u;
  const int n = lane & 15, q = lane >> 4, g = (lane >> 2) & 7;
  const int tr_r = (lane & 15) >> 1, tr_cc = lane & 1;
  const int imgaddr = (int)(uintptr_t)img;
  const int pj0 = (lane & 15) * 8 + (lane >> 4), pj1 = (lane & 15) * 8 + 4 + (lane >> 4);
  int stride = nrank * 8; asm volatile("" : "+s"(stride));
  const int t0 = rank * 8 + wid;
  if (t0 >= T) return;
  const int nit = (T - t0 + stride - 1) / stride;
#define V_TOK(I) (t0 + ((I) < nit ? (I) : nit - 1) * stride)
#define V_META_DMA(B, TT) do { LAS unsigned char* m_ = mb + (B) * VM_BYTES; \
    __builtin_amdgcn_global_load_lds(slt + (size_t)(TT) * 64 + lane, (LAS unsigned*)m_, 4, 0, 0); \
    __builtin_amdgcn_global_load_lds(hbuf + (size_t)(TT) * 64 + lane, (LAS unsigned*)(m_ + 256), 4, 0, 0); \
    __builtin_amdgcn_global_load_lds((const unsigned*)(xin + (size_t)(TT) * DM + s * 128) + lane, (LAS unsigned*)(m_ + 512), 4, 0, 0); } while (0)
#define V_STAGE(B, HB, EV, XO) do { const LAS unsigned char* m_ = mb + (B) * VM_BYTES; LAS unsigned char* hq_ = hqb + (HB) * 256; \
    _Pragma("unroll") for (int i_ = 0; i_ < 2; i_++) EV[i_] = *(const LAS u32x4*)(m_ + g * 32 + i_ * 16); \
    XO = *(const LAS u32x4*)(m_ + 512 + n * 16); \
    const float f0_ = bflo((unsigned)*(const LAS unsigned short*)(m_ + 256 + lane * 2)) * SH, f1_ = bflo((unsigned)*(const LAS unsigned short*)(m_ + 384 + lane * 2)) * SH; \
    const unsigned hh_ = __builtin_amdgcn_cvt_pk_fp8_f32(f0_, f1_, 0u, false); \
    const f32x2v bk_ = __builtin_amdgcn_cvt_pk_f32_fp8(hh_, false); \
    const unsigned ll_ = __builtin_amdgcn_cvt_pk_fp8_f32((f0_ - bk_.x) * 16.f, (f1_ - bk_.y) * 16.f, 0u, false); \
    hq_[pj0] = (unsigned char)(hh_ & 0xffu); hq_[pj1] = (unsigned char)((hh_ >> 8) & 0xffu); \
    hq_[128 + pj0] = (unsigned char)(ll_ & 0xffu); hq_[128 + pj1] = (unsigned char)((ll_ >> 8) & 0xffu); } while (0)
#define V_TAB_DMA(US, EV) do { _Pragma("unroll") for (int B_ = 4 * (US); B_ < 4 * (US) + 4; B_++) { \
      const unsigned dw_ = EV[B_ >> 2][B_ & 3]; const unsigned e_ = (lane & 32) ? (dw_ >> 16) : (dw_ & 0xffffu); const int pc_ = (lane & 3) ^ ((lane >> 4) & 1); \
      __builtin_amdgcn_global_load_lds((const unsigned*)(vts + (size_t)e_ * 64 + pc_ * 16), (LAS unsigned*)(img + B_ * 1024), 16, 0, 0); } } while (0)
#define V_TR(NB, BLK) tr8_read(imgaddr + (BLK) * 512 + tr_r * 64 + (((NB) ^ (tr_r >> 2)) * 16) + tr_cc * 8)
  u32x4 evn[2], xoc, xon;
  V_META_DMA(0, V_TOK(0)); V_META_DMA(1, V_TOK(1));
  asm volatile("s_waitcnt vmcnt(0)" ::: "memory");
  V_STAGE(0, 0, evn, xoc);
  asm volatile("s_waitcnt lgkmcnt(0)" ::: "memory");
  V_TAB_DMA(0, evn); V_TAB_DMA(1, evn);
  asm volatile("s_waitcnt vmcnt(0)" ::: "memory");
  for (int it = 0; it < nit; it += 2) {
#pragma unroll
    for (int u = 0; u < 2; u++) {
      const int ii = it + u;
      if (ii < nit) {
        const int t = t0 + ii * stride;
        asm volatile("s_waitcnt vmcnt(10)" ::: "memory");
        V_STAGE(u ^ 1, u ^ 1, evn, xon);
        asm volatile("s_waitcnt lgkmcnt(0)" ::: "memory");
        __builtin_amdgcn_sched_barrier(0);
        V_META_DMA(u, V_TOK(ii + 2));
        f32x4 acc[4];
#pragma unroll
        for (int nb = 0; nb < 4; nb++) acc[nb] = (f32x4){0.f, 0.f, 0.f, 0.f};
        const int afaddr = (n < 4) ? ((int)(uintptr_t)hqb + u * 256 + (n & 1) * 128 + q * 8) : (int)(uintptr_t)zb, afs = (n < 4) ? 1 : 0;
        const unsigned sel_lo = (n & 2) ? 0x010c000cu : 0x0c010c00u, sel_hi = (n & 2) ? 0x030c020cu : 0x0c030c02u;
        long af[2][2], bf[2][8];
        asm volatile("s_waitcnt vmcnt(9)" ::: "memory");
        af[0][0] = lds_read64(afaddr); af[0][1] = lds_read64(afaddr + 32 * afs);
#pragma unroll
        for (int nb = 0; nb < 4; nb++) { bf[0][2 * nb] = V_TR(nb, 2 * q); bf[0][2 * nb + 1] = V_TR(nb, 2 * q + 1); }
        asm volatile("s_waitcnt vmcnt(5)" ::: "memory");
        af[1][0] = lds_read64(afaddr + 64 * afs); af[1][1] = lds_read64(afaddr + 96 * afs);
#pragma unroll
        for (int nb = 0; nb < 4; nb++) { bf[1][2 * nb] = V_TR(nb, 8 + 2 * q); bf[1][2 * nb + 1] = V_TR(nb, 8 + 2 * q + 1); }
        __builtin_amdgcn_sched_barrier(0);
#pragma unroll
        for (int us = 0; us < 2; us++) {
          if (us == 0) asm volatile("s_waitcnt lgkmcnt(10)" ::: "memory"); else asm volatile("s_waitcnt lgkmcnt(0)" ::: "memory");
          __builtin_amdgcn_sched_barrier(0);
          if (us == 1) V_TAB_DMA(0, evn);
          i32x8 xa;
#pragma unroll
          for (int hh = 0; hh < 2; hh++) { const unsigned d0 = (unsigned)af[us][hh], d1 = (unsigned)((unsigned long long)af[us][hh] >> 32);
            xa[4 * hh + 0] = (int)__builtin_amdgcn_perm(0u, d0, sel_lo); xa[4 * hh + 1] = (int)__builtin_amdgcn_perm(0u, d0, sel_hi);
            xa[4 * hh + 2] = (int)__builtin_amdgcn_perm(0u, d1, sel_lo); xa[4 * hh + 3] = (int)__builtin_amdgcn_perm(0u, d1, sel_hi); }
#pragma unroll
          for (int nb = 0; nb < 4; nb++) {
            const long b0 = bf[us][2 * nb], b1 = bf[us][2 * nb + 1];
            const i32x8 bb = {(int)(unsigned)b0, (int)((unsigned long long)b0 >> 32), (int)(unsigned)b1, (int)((unsigned long long)b1 >> 32), 0, 0, 0, 0};
            acc[nb] = __builtin_amdgcn_mfma_scale_f32_16x16x128_f8f6f4(xa, bb, acc[nb], 0  , 4  , 0, 0x7f7f7f7f, 0, 0x7f7f7f7f);
          }
          __builtin_amdgcn_sched_barrier(0);
        }
        V_TAB_DMA(1, evn);
        __builtin_amdgcn_sched_barrier(0);
        float xn[8]; float ss = 0.f;
#pragma unroll
        for (int nb = 0; nb < 4; nb++) {
          xn[2 * nb] = bflo(xoc[nb]) + (acc[nb][0] + acc[nb][1] * (1.f / 16.f)) * (1.f / (SV * SH));
          xn[2 * nb + 1] = bfhi(xoc[nb]) + (acc[nb][2] + acc[nb][3] * (1.f / 16.f)) * (1.f / (SV * SH));
          ss += xn[2 * nb] * xn[2 * nb] + xn[2 * nb + 1] * xn[2 * nb + 1];
        }
        ss += __int_as_float(__builtin_amdgcn_update_dpp(0, __float_as_int(ss), 0x128, 0xf, 0xf, false));
        ss += __int_as_float(__builtin_amdgcn_update_dpp(0, __float_as_int(ss), 0x124, 0xf, 0xf, false));
        ss += __int_as_float(__builtin_amdgcn_update_dpp(0, __float_as_int(ss), 0x122, 0xf, 0xf, false));
        ss += __int_as_float(__builtin_amdgcn_update_dpp(0, __float_as_int(ss), 0x121, 0xf, 0xf, false));
        {
          if (q == 0) *(u32x4*)(xb + (size_t)t * DM + s * 128 + 8 * n) = (u32x4){pkbf(xn[0], xn[1]), pkbf(xn[2], xn[3]), pkbf(xn[4], xn[5]), pkbf(xn[6], xn[7])};
          if (lane == 0) ssq2[(size_t)t * 8 + s] = ss;
        }
        __builtin_amdgcn_sched_barrier(0);
        xoc = xon;
      }
    }
  }
  asm volatile("s_waitcnt vmcnt(0) lgkmcnt(0)" ::: "memory");
#undef V_TOK
#undef V_META_DMA
#undef V_STAGE
#undef V_TAB_DMA
#undef V_TR
}

struct EpiF32Scale {
  static constexpr bool PERM = false, AFTER_DRAIN = false;
  bf16_t* C; int ldc; const float* ssq2;
  __device__ __forceinline__ void operator()(const f32x4 (&acc)[2][2][4][2], const pg8::Unit& u, int wr, int wc, int fr, int fq) const {
    asm volatile("" : "+v"(fr), "+v"(fq));
    const int row0 = u.pm * 256 + wr * 64 + fr, col0 = u.pn * 256 + wc * 32 + 4 * fq;
    f32x4 s0[2][4], s1[2][4];
#pragma unroll
    for (int ai = 0; ai < 2; ++ai)
#pragma unroll
      for (int m = 0; m < 4; ++m) { const size_t row = (size_t)(row0 + ai * 128 + m * 16); s0[ai][m] = *(const f32x4*)(ssq2 + row * 8); s1[ai][m] = *(const f32x4*)(ssq2 + row * 8 + 4); }
    __builtin_amdgcn_sched_barrier(0);
#pragma unroll
    for (int ai = 0; ai < 2; ++ai)
#pragma unroll
      for (int m = 0; m < 4; ++m) {
        const int row = row0 + ai * 128 + m * 16;
        const f32x4 sv = s0[ai][m] + s1[ai][m];
        const float r = rsqrtf((sv[0] + sv[1] + sv[2] + sv[3]) * (1.f / DM) + EPS);
        bf16_t* rowp = C + (size_t)row * ldc + col0;
#pragma unroll
        for (int bj = 0; bj < 2; ++bj)
#pragma unroll
          for (int n = 0; n < 2; ++n) { const f32x4 v = acc[ai][bj][m][n] * r; u32x2 w; w.x = pkbf(v[0], v[1]); w.y = pkbf(v[2], v[3]); *(u32x2*)(rowp + bj * 128 + n * 16) = w; }
      }
  }
};

__device__ __forceinline__ void final_norm_phase(const Params& p) {
  const int tid = opaque_tid(), lane = tid & 63, wid = tid >> 6;
  const int gw = blockIdx.x * 8 + wid, nw = gridDim.x * 8;
  const float* ssq2 = (const float*)(p.ws + WS_SSQ2);
  const float* g = p.in[17];
  float* xr = p.out; const bf16_t* x4 = (const bf16_t*)(p.ws + WS_MISC + MS_X3B);
  f32x4 gv[4];
#pragma unroll
  for (int i = 0; i < 4; i++) gv[i] = *(const f32x4*)(g + lane * 16 + i * 4);
  for (int t0 = gw; t0 < T; t0 += 2 * nw) {
    u32x4 v[2][2]; f32x4 s0[2], s1[2];
#pragma unroll
    for (int k = 0; k < 2; k++) { const int t = (t0 + k * nw < T) ? (t0 + k * nw) : t0;
      s0[k] = *(const f32x4*)(ssq2 + (size_t)t * 8); s1[k] = *(const f32x4*)(ssq2 + (size_t)t * 8 + 4);
#pragma unroll
      for (int i = 0; i < 2; i++) v[k][i] = *(const u32x4*)(x4 + (size_t)t * DM + lane * 16 + i * 8); }
#pragma unroll
    for (int k = 0; k < 2; k++) {
      const int t = t0 + k * nw;
      const f32x4 sv = s0[k] + s1[k];
      const float r = rsqrtf((sv[0] + sv[1] + sv[2] + sv[3]) * (1.f / DM) + EPS);
      if (t < T) {
#pragma unroll
        for (int i = 0; i < 4; i++) { const unsigned wa = v[k][i >> 1][2 * (i & 1)], wb = v[k][i >> 1][2 * (i & 1) + 1];
          *(f32x4*)(xr + (size_t)t * DM + lane * 16 + i * 4) = (f32x4){bflo(wa), bfhi(wa), bflo(wb), bfhi(wb)} * r * gv[i]; }
      }
    }
  }
}

__device__ __forceinline__ void latnorm_phase(const Params& p) {
  const int tid = opaque_tid(), lane = tid & 63, wid = tid >> 6;
  const int gw = blockIdx.x * 8 + wid, nw = gridDim.x * 8;
  const bf16_t* lat = (const bf16_t*)(p.ws + WS_BIG + BG_LATQ);
  bf16_t* cq = (bf16_t*)(p.ws + WS_MISC + MS_CQ);
  bf16_t* ckv = (bf16_t*)(p.ws + WS_MISC + MS_CKV);
  bf16_t* kr = (bf16_t*)(p.ws + WS_MISC + MS_KR);
  const float* qn = p.in[7]; const float* kvn = p.in[8];
  const float* rc = (const float*)(p.ws + WS_ROPE); const float* rs = rc + 2048 * 16;
  float gq[6], gk[4];
#pragma unroll
  for (int i = 0; i < 6; i++) gq[i] = qn[lane * 6 + i];
#pragma unroll
  for (int i = 0; i < 4; i++) gk[i] = kvn[lane * 4 + i];
  for (int t0 = gw; t0 < T; t0 += 2 * nw) {
    float a[2][6]; f32x4 b[2]; float x1[2], x2[2];
#pragma unroll
    for (int k = 0; k < 2; k++) {
      const int t = (t0 + k * nw < T) ? (t0 + k * nw) : t0;
      const bf16_t* lr = lat + (size_t)t * 768;
#pragma unroll
      for (int i = 0; i < 3; i++) { const unsigned v = *(const unsigned*)(lr + lane * 6 + 2 * i); a[k][2 * i] = bflo(v); a[k][2 * i + 1] = bfhi(v); }
      { const u32x2 v = *(const u32x2*)(lr + 384 + lane * 4); b[k] = (f32x4){bflo(v.x), bfhi(v.x), bflo(v.y), bfhi(v.y)}; }
      x1[k] = bflo((unsigned)lr[640 + (lane & 15)]); x2[k] = bflo((unsigned)lr[656 + (lane & 15)]);
    }
#pragma unroll
    for (int k = 0; k < 2; k++) {
      const int t = t0 + k * nw;
      float s1 = 0.f, s2 = 0.f;
#pragma unroll
      for (int i = 0; i < 6; i++) s1 += a[k][i] * a[k][i];
      s2 = b[k][0] * b[k][0] + b[k][1] * b[k][1] + b[k][2] * b[k][2] + b[k][3] * b[k][3];
      s1 = wave_sum(s1); s2 = wave_sum(s2);
      const float r1 = rsqrtf(s1 * (1.f / 384.f) + EPS), r2 = rsqrtf(s2 * (1.f / 256.f) + EPS);
      if (t < T) {
        unsigned* cqp = (unsigned*)(cq + (size_t)t * 384 + lane * 6);
#pragma unroll
        for (int i = 0; i < 3; i++) cqp[i] = pkbf(a[k][2 * i] * r1 * gq[2 * i], a[k][2 * i + 1] * r1 * gq[2 * i + 1]);
        u32x2 w; w.x = pkbf(b[k][0] * r2 * gk[0], b[k][1] * r2 * gk[1]); w.y = pkbf(b[k][2] * r2 * gk[2], b[k][3] * r2 * gk[3]);
        *(u32x2*)(ckv + (size_t)t * 256 + lane * 4) = w;
        if (lane < 16) {
          const int pos = t & (SEQ - 1);
          const float c = rc[pos * 16 + lane], sn = rs[pos * 16 + lane];
          const unsigned o1 = pkbf(x1[k] * c - x2[k] * sn, 0.f), o2 = pkbf(x2[k] * c + x1[k] * sn, 0.f);
          kr[(size_t)t * 32 + lane] = (bf16_t)(o1 & 0xffffu);
          kr[(size_t)t * 32 + 16 + lane] = (bf16_t)(o2 & 0xffffu);
        }
      }
    }
  }
}

namespace att {
using f32x16 = __attribute__((ext_vector_type(16))) float;
using s16x4 = __attribute__((ext_vector_type(4))) short;
constexpr int NW = 8, QBLK = 32, KVBLK = 64;
constexpr float SCALE = 0.10206207261596575f;
constexpr float THR = 8.f;
constexpr int LDQ = 1536, LDKV = 2048, LDR = 32, LDO = 1024;
constexpr int SHM_V = KVBLK * 128 * 2, SHM_K = KVBLK * 128 * 2;
#define KSWZ(row, colB) ((row) * 256 + ((colB) ^ (((row) & 7) << 4)))
#define SBAR() __builtin_amdgcn_sched_barrier(0)
__device__ __forceinline__ int crow(int r, int hi) { return (r & 3) + 8 * (r >> 2) + 4 * hi; }
__device__ __forceinline__ unsigned cvtpk(float lo, float hi) { unsigned r; asm volatile("v_cvt_pk_bf16_f32 %0, %1, %2" : "=v"(r) : "v"(lo), "v"(hi)); return r; }

__device__ __forceinline__ void partialSM(f32x16& p0, f32x16& p1, float& m_reg, float& mn, float& alpha) {
  constexpr float C = SCALE * 1.4426950408889634f;
  float pmax = p0[0];
#pragma unroll
  for (int r = 1; r < 16; ++r) pmax = fmaxf(pmax, p0[r]);
#pragma unroll
  for (int r = 0; r < 16; ++r) pmax = fmaxf(pmax, p1[r]);
  { auto rr = __builtin_amdgcn_permlane32_swap(__float_as_uint(pmax), __float_as_uint(pmax), false, false);
    pmax = fmaxf(__uint_as_float(rr[0]), __uint_as_float(rr[1])); }
  if (__builtin_expect(__all(pmax - m_reg <= THR / SCALE), 1)) { mn = m_reg; alpha = 1.f; }
  else { mn = fmaxf(m_reg, pmax); alpha = __builtin_amdgcn_exp2f((m_reg - mn) * C); m_reg = mn; }
  const float mnC = -mn * C;
#pragma unroll
  for (int r = 0; r < 16; ++r) p0[r] = fmaf(p0[r], C, mnC);
#pragma unroll
  for (int r = 0; r < 16; ++r) p1[r] = fmaf(p1[r], C, mnC);
#pragma unroll
  for (int r = 0; r < 16; ++r) p0[r] = __builtin_amdgcn_exp2f(p0[r]);
}
__device__ __forceinline__ void finishSM(f32x16& p0, f32x16& p1, float alpha, float& l_reg, bf16x8& pa0, bf16x8& pa1, bf16x8& pa2, bf16x8& pa3) {
#pragma unroll
  for (int r = 0; r < 16; ++r) p1[r] = __builtin_amdgcn_exp2f(p1[r]);
  float ps = 0;
#pragma unroll
  for (int r = 0; r < 16; ++r) ps += p0[r];
#pragma unroll
  for (int r = 0; r < 16; ++r) ps += p1[r];
  { auto rr = __builtin_amdgcn_permlane32_swap(__float_as_uint(ps), __float_as_uint(ps), false, false);
    ps = __uint_as_float(rr[0]) + __uint_as_float(rr[1]); }
  l_reg = l_reg * alpha + ps;
#define PK4(P, BASE, OUT) do { unsigned a0 = cvtpk(P[BASE + 0], P[BASE + 1]), a1 = cvtpk(P[BASE + 2], P[BASE + 3]);   \
    unsigned b0 = cvtpk(P[BASE + 4], P[BASE + 5]), b1 = cvtpk(P[BASE + 6], P[BASE + 7]);                              \
    auto r0 = __builtin_amdgcn_permlane32_swap(a0, b0, false, false); auto r1 = __builtin_amdgcn_permlane32_swap(a1, b1, false, false); \
    u32x4 w = {r0[0], r1[0], r0[1], r1[1]}; OUT = *reinterpret_cast<bf16x8*>(&w); } while (0)
  PK4(p0, 0, pa0); PK4(p0, 8, pa1); PK4(p1, 0, pa2); PK4(p1, 8, pa3);
#undef PK4
}
__device__ __forceinline__ void qkt(f32x16& p0, f32x16& p1, const LAS unsigned char* Ks, const bf16x8* qr, int r32, int hi) {
  p0 = f32x16{}; p1 = f32x16{};
#pragma unroll
  for (int d0 = 0; d0 < 6; ++d0) { const int cb = (d0 * 16 + hi * 8) * 2;
    const bf16x8 b0 = *reinterpret_cast<const LAS bf16x8*>(Ks + KSWZ(r32, cb));
    const bf16x8 b1 = *reinterpret_cast<const LAS bf16x8*>(Ks + KSWZ(32 + r32, cb));
    p0 = __builtin_amdgcn_mfma_f32_32x32x16_bf16(b0, qr[d0], p0, 0, 0, 0);
    p1 = __builtin_amdgcn_mfma_f32_32x32x16_bf16(b1, qr[d0], p1, 0, 0, 0); }
}
__device__ __forceinline__ int v_st(int k, int c) { const int kk = (k & ~0xC) | ((k & 4) << 1) | ((k & 8) >> 1); return ((kk >> 3) * 4 + (c >> 5)) * 512 + ((kk & 7) * 32 + (c & 31)) * 2; }
__device__ __forceinline__ int v_rd_base(int lane) { return ((lane & 3) << 3) | (((lane >> 2) & 3) << 6) | (((lane >> 4) & 1) << 5) | (((lane >> 5) & 1) << 8); }
constexpr int v_rd_off(int d0, int ks, int half) { return d0 * 512 + ks * 4096 + half * 2048; }
template <int OFF> __device__ __forceinline__ s16x4 tr_read(int vb) {
  s16x4 r; asm volatile("ds_read_b64_tr_b16 %0, %1 offset:%2" : "=&v"(r) : "v"(vb), "i"(OFF) : "memory"); return r;
}
template <int D0> __device__ __forceinline__ void pv_one(f32x16& od, int vb, bf16x8 pa0, bf16x8 pa1, bf16x8 pa2, bf16x8 pa3) {
  const s16x4 l0 = tr_read<v_rd_off(D0, 0, 0)>(vb), h0 = tr_read<v_rd_off(D0, 0, 1)>(vb), l1 = tr_read<v_rd_off(D0, 1, 0)>(vb), h1 = tr_read<v_rd_off(D0, 1, 1)>(vb);
  const s16x4 l2 = tr_read<v_rd_off(D0, 2, 0)>(vb), h2 = tr_read<v_rd_off(D0, 2, 1)>(vb), l3 = tr_read<v_rd_off(D0, 3, 0)>(vb), h3 = tr_read<v_rd_off(D0, 3, 1)>(vb);
  asm volatile("s_waitcnt lgkmcnt(0)" ::: "memory"); SBAR();
#define PK(L, H) (bf16x8){L[0], L[1], L[2], L[3], H[0], H[1], H[2], H[3]}
  od = __builtin_amdgcn_mfma_f32_32x32x16_bf16(pa0, PK(l0, h0), od, 0, 0, 0);
  od = __builtin_amdgcn_mfma_f32_32x32x16_bf16(pa1, PK(l1, h1), od, 0, 0, 0);
  od = __builtin_amdgcn_mfma_f32_32x32x16_bf16(pa2, PK(l2, h2), od, 0, 0, 0);
  od = __builtin_amdgcn_mfma_f32_32x32x16_bf16(pa3, PK(l3, h3), od, 0, 0, 0);
#undef PK
}
__device__ __forceinline__ void pv_d0(f32x16* o, int vb, bf16x8 pa0, bf16x8 pa1, bf16x8 pa2, bf16x8 pa3) {
  pv_one<0>(o[0], vb, pa0, pa1, pa2, pa3); pv_one<1>(o[1], vb, pa0, pa1, pa2, pa3);
}

__device__ __forceinline__ void attn_body(const bf16_t* __restrict__ Qb, const bf16_t* __restrict__ KVh, const bf16_t* __restrict__ KRb,
                                          bf16_t* __restrict__ Ob, int seq, LAS unsigned char* lds) {
  const int tid = opaque_tid(), wid = tid >> 6, lane = tid & 63, r32 = lane & 31, hi = lane >> 5;
  LAS unsigned char* V_lds = lds; LAS unsigned char* K_lds = lds + 3 * SHM_V;
  LAS float* wsf = (LAS float*)(lds + 3 * SHM_V + 3 * SHM_K) + wid * 64; LAS float* li_l = wsf; LAS float* al_l = wsf + 32;
  float m_reg = -1e30f, l_reg = 0; f32x16 o[2] = {}; bf16x8 qr[6];
  const bf16_t* Qw = Qb + (long)(wid * QBLK + r32) * LDQ + hi * 8;
#pragma unroll
  for (int d0 = 0; d0 < 6; ++d0) qr[d0] = *reinterpret_cast<const bf16x8*>(Qw + d0 * 16);
  const int sr = tid >> 4, sc = (tid & 15) * 8, vst0 = v_st(sr, sc), vst1 = v_st(32 + sr, sc);
  const bf16_t* kbase = (sc < 64) ? (KVh + sc) : (KRb + ((sc - 64) & 31));
  const long kstr = (sc < 64) ? LDKV : LDR;
  const bf16_t* vbase = KVh + 64 + (sc & 63);
  const int vb0 = (int)(uintptr_t)V_lds + v_rd_base(lane);
  struct { bf16x8 vs0, vs1, ks0, ks1; } sr_[2];
#define SLOAD(i, k0) do { sr_[i].vs0 = *reinterpret_cast<const bf16x8*>(vbase + (long)((k0) + sr) * LDKV); \
    sr_[i].vs1 = *reinterpret_cast<const bf16x8*>(vbase + (long)((k0) + 32 + sr) * LDKV); \
    sr_[i].ks0 = *reinterpret_cast<const bf16x8*>(kbase + (long)((k0) + sr) * kstr); \
    sr_[i].ks1 = *reinterpret_cast<const bf16x8*>(kbase + (long)((k0) + 32 + sr) * kstr); } while (0)
#define SWRITE(b, i) do { *(LAS bf16x8*)(V_lds + (b) + vst0) = sr_[i].vs0;          \
    *(LAS bf16x8*)(V_lds + (b) + vst1) = sr_[i].vs1; const int kc = sc * 2;               \
    *(LAS bf16x8*)(K_lds + (b) + KSWZ(sr, kc)) = sr_[i].ks0;                       \
    *(LAS bf16x8*)(K_lds + (b) + KSWZ(32 + sr, kc)) = sr_[i].ks1; } while (0)
#define SWAIT() asm volatile("s_waitcnt vmcnt(4)" ::: "memory")
#define RESC(a) do { if (__any((a) < 1.f)) { if (hi == 0) al_l[r32] = (a); asm volatile("s_waitcnt lgkmcnt(0)" ::: "memory"); \
    _Pragma("unroll") for (int d = 0; d < 2; ++d) _Pragma("unroll") for (int r = 0; r < 16; ++r) o[d][r] *= al_l[crow(r, hi)]; } } while (0)
  f32x16 pA0, pA1, pB0, pB1; float mnA, mnB, alA, alB; bf16x8 pa0, pa1, pa2, pa3; const int NT = seq / KVBLK;
  constexpr int SE = 0, SO = 1;
  SLOAD(SE, 0); asm volatile("s_waitcnt vmcnt(0)" ::: "memory"); SWRITE(0, SE); __syncthreads();
  qkt(pA0, pA1, K_lds, qr, r32, hi); partialSM(pA0, pA1, m_reg, mnA, alA);
  SLOAD(SO, KVBLK); if (2 < NT) SLOAD(SE, 2 * KVBLK);
  SWAIT(); SWRITE(SHM_V, SO);
  int bp = 0, bq = SHM_V, bw = 2 * SHM_V;
#define ROT() do { bp = bq; bq = bw; bw = (bw == 2 * SHM_V) ? 0 : bw + SHM_V; } while (0)
  for (int j = 1; j + 1 < NT; j += 2) {
    __syncthreads();
    SBAR(); qkt(pB0, pB1, K_lds + bq, qr, r32, hi);
    finishSM(pA0, pA1, alA, l_reg, pa0, pa1, pa2, pa3); SBAR();
    SLOAD(SO, (j + 2) * KVBLK); SBAR();
    pv_d0(o, vb0 + bp, pa0, pa1, pa2, pa3); partialSM(pB0, pB1, m_reg, mnB, alB);
    SWAIT(); SWRITE(bw, SE);
    RESC(alB); ROT();
    __syncthreads();
    SBAR(); qkt(pA0, pA1, K_lds + bq, qr, r32, hi);
    finishSM(pB0, pB1, alB, l_reg, pa0, pa1, pa2, pa3); SBAR();
    if (j + 3 < NT) SLOAD(SE, (j + 3) * KVBLK); SBAR();
    pv_d0(o, vb0 + bp, pa0, pa1, pa2, pa3); partialSM(pA0, pA1, m_reg, mnA, alA);
    SWAIT(); SWRITE(bw, SO);
    RESC(alA); ROT();
  }
  __syncthreads();
  SBAR(); qkt(pB0, pB1, K_lds + bq, qr, r32, hi);
  finishSM(pA0, pA1, alA, l_reg, pa0, pa1, pa2, pa3); SBAR();
  pv_d0(o, vb0 + bp, pa0, pa1, pa2, pa3); partialSM(pB0, pB1, m_reg, mnB, alB);
  RESC(alB);
  finishSM(pB0, pB1, alB, l_reg, pa0, pa1, pa2, pa3); SBAR();
  pv_d0(o, vb0 + bq, pa0, pa1, pa2, pa3);
#undef ROT
  if (hi == 0) li_l[r32] = l_reg; asm volatile("s_waitcnt lgkmcnt(0)" ::: "memory");
  float rli[16];
#pragma unroll
  for (int r = 0; r < 16; ++r) rli[r] = __builtin_amdgcn_rcpf(li_l[crow(r, hi)]);
  bf16_t* Ow = Ob + (long)(wid * QBLK) * LDO;
  LAS unsigned char* osc = lds + 100 * 1024 + wid * 4096;
#pragma unroll
  for (int r = 0; r < 16; ++r) { const int orow = crow(r, hi);
#pragma unroll
    for (int d0 = 0; d0 < 2; ++d0) *(LAS bf16_t*)(osc + orow * 128 + (d0 * 32 + r32) * 2) = (bf16_t)(cvtpk(o[d0][r] * rli[r], 0.f) & 0xffffu); }
#pragma unroll
  for (int i = 0; i < 4; ++i) { const u32x4 w = *(const LAS u32x4*)(osc + i * 1024 + lane * 16);
    *(u32x4*)(Ow + (long)(8 * i + (lane >> 3)) * LDO + (lane & 7) * 8) = w; }
  __syncthreads();
#undef SLOAD
#undef SWRITE
#undef SWAIT
#undef RESC
}
#undef KSWZ
#undef SBAR
}

__device__ __forceinline__ void attn_phase(const Params& p, LAS unsigned char* lds) {
  const bf16_t* Q = (const bf16_t*)(p.ws + WS_BIG + BG_LATQ);
  const bf16_t* KV = (const bf16_t*)(p.ws + WS_BIG + BG_KV);
  const bf16_t* KR = (const bf16_t*)(p.ws + WS_MISC + MS_KR);
  bf16_t* O = (bf16_t*)p.out;
  for (int it = blockIdx.x; it < 4096; it += gridDim.x) {
    const int rnd = it >> 8, cc = it & 255;
    const int pair = rnd * 32 + (cc & 7) * 4 + ((cc >> 3) >> 3), qb = (cc >> 3) & 7;
    const int b = pair >> 4, h = pair & 15;
    const size_t tok0 = (size_t)b * SEQ;
    att::attn_body(Q + (tok0 + qb * 256) * 1536 + h * 96, KV + tok0 * 2048 + h * 128, KR + tok0 * 32,
                   O + (tok0 + qb * 256) * 1024 + h * 64, SEQ, lds);
  }
}

constexpr int NPH = 19;
#ifndef PHM
#define PHM 0xfffff
#endif
__global__ void __launch_bounds__(512, 2) mega_fwd(Params p) {
  extern __shared__ __attribute__((aligned(16))) unsigned char lds_raw[];
  LAS unsigned char* lds = (LAS unsigned char*)lds_raw;
  cg::grid_group grid = cg::this_grid();
  volatile LAS unsigned* bst = (volatile LAS unsigned*)(lds + LDS_BYTES - 16);
  if (threadIdx.x == 0) { bst[0] = 0u; bst[1] = 0u; }
  __syncthreads();
  XcdBarrier xbar = xcd_barrier_post((unsigned*)(p.ws + WS_BAR), bst);
  volatile LAS unsigned* shw = (volatile LAS unsigned*)(lds + LDS_BYTES - 32);
  if (threadIdx.x == 0) { const unsigned x = xb_xcc_id() & 7u; shw[0] = x; shw[1] = atomicAdd((unsigned*)(p.ws + WS_BAR) + 3500 + 64 * x, 1u); }
  __syncthreads();
  pg8::StaticOrder S;
#ifdef PROBE_A
  unsigned long long* stamps = (unsigned long long*)(p.ws + WS_END);
  if (blockIdx.x == 0 && threadIdx.x == 0) stamps[0] = __builtin_amdgcn_s_memrealtime();
#endif
  int repeated = 0; (void)repeated;
  for (int ph = p.ph_lo; ph < p.ph_hi; ++ph) {
    __attribute__((address_space(1))) unsigned char* wsg = (__attribute__((address_space(1))) unsigned char*)p.ws; asm volatile("" : "+s"(wsg));
    unsigned char* ws = (unsigned char*)wsg;
    const int l = (ph >= 13) ? 1 : 0;
    switch (ph) {
      case 0: if (PHM & 1) prep_phase(p, lds); break;
      case 1: if (PHM & 2) {
        pg8::Gemm g{(const bf16_t*)(ws + WS_XB), (const bf16_t*)(ws + WS_BT1), T, 3072, 1024};
        S.init(g.M, g.N, (int)gridDim.x, (int)blockIdx.x);
        EpiConv E{(bf16_t*)(ws + WS_BIG + BG_BB), (bf16_t*)(ws + WS_BIG + BG_UB)};
        pg8::gemm_phase<EpiConv, pg8::StaticOrder, false>(lds, g, S, E, nullptr);
      } break;
      case 2: if (PHM & 4) convz_phase(p); break;
      case 3: case 13: if (PHM & 8) {
        const bool first = (ph == 3);
        pg8::Gemm g{first ? (const bf16_t*)(ws + WS_BIG + BG_BB) : (const bf16_t*)p.out, first ? (const bf16_t*)(ws + WS_BT2) : (const bf16_t*)(ws + WS_BT9), T, 1024, 1024};
        S.init(g.M, g.N, (int)gridDim.x, (int)blockIdx.x);
        EpiResid<true> E{(const void*)(ws + WS_XB), first ? (bf16_t*)(ws + WS_XB) : (bf16_t*)(ws + WS_MISC + MS_X3B), (float*)(ws + WS_SSQ), first ? (const float*)(ws + WS_ASC) : (const float*)nullptr};
        pg8::gemm_phase<EpiResid<true>, pg8::StaticOrder, false>(lds, g, S, E, nullptr);
      } break;
      case 4: case 14: if (PHM & 16) {
        pg8::Gemm g{l ? (const bf16_t*)(ws + WS_MISC + MS_X3B) : (const bf16_t*)(ws + WS_XB), (const bf16_t*)(ws + WS_BT3) + (size_t)l * 2048 * 1024, T, 2048, 1024};
        S.init(g.M, g.N, (int)gridDim.x, (int)blockIdx.x);
        pg8::EpiBf16<0> E{(bf16_t*)(ws + WS_BIG + BG_SCORES), 2048, nullptr, 0, 0};
        pg8::gemm_phase<pg8::EpiBf16<0>, pg8::StaticOrder, false>(lds, g, S, E, nullptr);
      } break;
      case 5: case 15: if (PHM & 32) topk_phase(p, lds, l); break;
      case 6: case 16: if (PHM & 64) {
#ifdef REPEAT_U
        for (int rep = 0; rep < 2; ++rep) { int uv = rep ? REPEAT_U : 0; asm volatile("" : "+s"(uv)); if (rep) xcd_barrier(xbar); peer_u_phase(p, l, lds, uv); }
#else
        peer_u_phase(p, l, lds, 0);
#endif
      } break;
      case 7: case 17: if (PHM & 4096) { peer_v_phase(p, l, lds);
#ifdef REPEAT_V
        xcd_barrier(xbar); peer_v_phase(p, l, lds, 1);
#endif
      } break;
      case 8: if (PHM & 128) {
        pg8::Gemm g{(const bf16_t*)(ws + WS_XB), (const bf16_t*)(ws + WS_BT5), T, 768, 1024};
        S.init(g.M, g.N, (int)gridDim.x, (int)blockIdx.x);
        EpiF32Scale E{(bf16_t*)(ws + WS_BIG + BG_LATQ), 768, (const float*)(ws + WS_SSQ2)};
        pg8::gemm_phase<EpiF32Scale, pg8::StaticOrder, false>(lds, g, S, E, nullptr);
      } break;
      case 9: if (PHM & 256) latnorm_phase(p); break;
      case 10: if (PHM & 512) {
        pg8::Gemm g{(const bf16_t*)(ws + WS_MISC + MS_CQ), (const bf16_t*)(ws + WS_BT6), T, 1536, 384};
        S.init(g.M, g.N, (int)gridDim.x, (int)blockIdx.x);
        EpiQ E{(bf16_t*)(ws + WS_BIG + BG_LATQ), (const float*)(ws + WS_ROPE), (const float*)(ws + WS_ROPE) + 2048 * 16};
        pg8::gemm_phase<EpiQ, pg8::StaticOrder, false>(lds, g, S, E, nullptr);
      } break;
      case 11: if (PHM & 2048) {
        pg8::Gemm g{(const bf16_t*)(ws + WS_MISC + MS_CKV), (const bf16_t*)(ws + WS_BT7), T, 2048, 256};
        S.init(g.M, g.N, (int)gridDim.x, (int)blockIdx.x);
        pg8::EpiBf16<0> E{(bf16_t*)(ws + WS_BIG + BG_KV), 2048, nullptr, 0, 0};
        pg8::gemm_phase<pg8::EpiBf16<0>, pg8::StaticOrder, false>(lds, g, S, E, nullptr);
      } break;
      case 12: if (PHM & 1024) attn_phase(p, lds); break;
      case 18: if (PHM & 8192) final_norm_phase(p); break;
      default: break;
    }
#ifdef PROBE_A
    grid.sync();
    if (blockIdx.x == 0 && threadIdx.x == 0) stamps[ph + 1] = __builtin_amdgcn_s_memrealtime();
#else
#ifdef REPEAT_PH
    if (ph == REPEAT_PH && !repeated) { repeated = 1; xcd_barrier(xbar); --ph; continue; }
#endif
    if (ph + 1 < p.ph_hi) { if (ph == 10) __syncthreads(); else if (ph == 0) grid.sync(); else xcd_barrier(xbar); }
#endif
  }
#ifdef PROBE_A
  __threadfence(); grid.sync();
  {
    const volatile unsigned long long* st = stamps;
    const float qa = exp2f(rintf(log2f((float)(st[PROBE_A + 1] - st[PROBE_A]) * 0.01f) * PROBE_Q) * (1.0f / PROBE_Q));
    const float qb = exp2f(rintf(log2f((float)(st[PROBE_B + 1] - st[PROBE_B]) * 0.01f) * PROBE_Q) * (1.0f / PROBE_Q));
    const float ka = qa / (float)PROBE_KDIV;
    const float vb = qb / (float)PROBE_VDIV;
    for (size_t i = (size_t)blockIdx.x * 512 + threadIdx.x; i < (size_t)T * DM; i += (size_t)gridDim.x * 512) p.out[i] = (i == 0) ? vb : ka;
  }
#endif
}

#ifndef MK_SPLIT
#define MK_SPLIT 0
#endif
extern "C" void kernel_launch(void* const* d_in, const int* in_sizes, int n_in, void* d_out, int out_size, void* d_ws, size_t ws_size, hipStream_t stream) {
  static int grid = 0;
  if (grid == 0) {
    if (n_in != 18 || out_size != T * DM || ws_size < WS_END) { fprintf(stderr, "kernel_launch: unexpected shapes (n_in %d out %d ws %zu need %zu)\n", n_in, out_size, ws_size, (size_t)WS_END); grid = -1; return; }
    int dev = 0, cus = 0, per_cu = 0;
    if (hipGetDevice(&dev) != hipSuccess || hipDeviceGetAttribute(&cus, hipDeviceAttributeMultiprocessorCount, dev) != hipSuccess) { grid = -1; return; }
    if (hipFuncSetAttribute((const void*)mega_fwd, hipFuncAttributeMaxDynamicSharedMemorySize, LDS_BYTES) != hipSuccess) { fprintf(stderr, "kernel_launch: hipFuncSetAttribute failed\n"); grid = -1; return; }
    if (hipOccupancyMaxActiveBlocksPerMultiprocessor(&per_cu, (const void*)mega_fwd, 512, LDS_BYTES) != hipSuccess || per_cu < 1) { fprintf(stderr, "kernel_launch: occupancy query failed (%d)\n", per_cu); grid = -1; return; }
    if (cus < 8 || (cus % 8) != 0) { fprintf(stderr, "kernel_launch: CU count %d is not a multiple of 8\n", cus); grid = -1; return; }
    grid = cus * 1;
  }
  if (grid < 0) return;
  Params p{};
  for (int i = 0; i < 18; ++i) p.in[i] = (const float*)d_in[i];
  p.out = (float*)d_out; p.ws = (unsigned char*)d_ws;
  (void)hipMemsetAsync((unsigned char*)d_ws + WS_BAR, 0, (size_t)XCD_BAR_WORDS * 4 + 4096, stream);
#if MK_SPLIT
  for (int ph = 0; ph < NPH; ++ph) {
    p.ph_lo = ph; p.ph_hi = ph + 1;
    void* args[] = {&p};
    hipError_t e = hipLaunchCooperativeKernel((const void*)mega_fwd, dim3(grid), dim3(512), args, LDS_BYTES, stream);
    if (e != hipSuccess) fprintf(stderr, "launch failed: %s\n", hipGetErrorString(e));
  }
#else
  p.ph_lo = 0; p.ph_hi = NPH;
  void* args[] = {&p};
  hipError_t e = hipLaunchCooperativeKernel((const void*)mega_fwd, dim3(grid), dim3(512), args, LDS_BYTES, stream);
  if (e != hipSuccess) fprintf(stderr, "cooperative launch failed: %s (grid %d)\n", hipGetErrorString(e), grid);
#endif
}
```
